# Optimizing an MI355X kernel written in HIP

```python
import jax, jax.numpy as jnp
from jax import lax
import numpy as np

D_MODEL = 1024
BATCH = 8
SEQ = 2048
DEPTH = 4
DEC_BATCH = 128
DEC_SEQ = 4
PAST_LEN = 16384
PAGE_SIZE = 128

CHUNK = 128
D_A = D_MODEL // 2
N_A_GROUPS = 4
A_GROUP = D_A // N_A_GROUPS
D_B = D_MODEL // 2
CONV_W = 3
D_C = D_MODEL // 2
POOL_WINDOWS = (2, 4, 8, 16)
N_C_GROUPS = len(POOL_WINDOWS)
C_GROUP = D_C // N_C_GROUPS
POOL_BUF = max(POOL_WINDOWS) - 1
N_BRANCH = 3
D_FF = 2816
EPS = 1e-6
SPLITS = (D_A, 2 * D_A, 2 * D_A + D_B, 2 * D_A + 2 * D_B, 2 * D_A + 3 * D_B, 2 * D_A + 3 * D_B + D_C)
D_IN = 2 * D_A + 3 * D_B + D_C + N_BRANCH * D_MODEL

kernel_name = "hybrid_gmlp_conv_pool_decoder_step"


def rms_norm(x, g):
    xf = x.astype(jnp.float32)
    y = xf * lax.rsqrt(jnp.mean(xf * xf, axis=-1, keepdims=True) + EPS)
    return (y * g.astype(jnp.float32)).astype(x.dtype)


def layer_norm(x, g, b):
    xf = x.astype(jnp.float32)
    mu = jnp.mean(xf, axis=-1, keepdims=True)
    xc = xf - mu
    y = xc * lax.rsqrt(jnp.mean(xc * xc, axis=-1, keepdims=True) + EPS)
    return (y * g.astype(jnp.float32) + b.astype(jnp.float32)).astype(x.dtype)


def swiglu(x, w_gu, w_down):
    g, u = jnp.split(x @ w_gu, 2, axis=-1)
    return (jax.nn.silu(g) * u) @ w_down


def chunk_spatial_gate(u, v, w_s, b_s):
    bn, L, _ = v.shape
    c = min(L, CHUNK)
    n = L // c
    mask = jnp.tril(jnp.ones((c, c), dtype=bool))
    ws = jnp.where(mask[None], w_s[:, :c, :c], jnp.zeros((), w_s.dtype)).astype(v.dtype)
    vr = v.reshape(bn, n, c, N_A_GROUPS, A_GROUP)
    mixed = jnp.einsum('gts,bnsgc->bntgc', ws, vr) + b_s[:, :c].T[None, None, :, :, None].astype(v.dtype)
    return u * mixed.reshape(bn, L, D_A)


def short_conv(z_ext, w_conv, L):
    return sum(w_conv[k] * z_ext[:, k:k + L] for k in range(CONV_W))


def multi_pool(p_ext, start_pos, L):
    pf = p_ext.astype(jnp.float32)
    cs = jnp.concatenate([jnp.zeros_like(pf[:, :1]), jnp.cumsum(pf, axis=1)], axis=1)
    pos = start_pos + jnp.arange(L)
    outs = []
    for g, w in enumerate(POOL_WINDOWS):
        sl = slice(g * C_GROUP, (g + 1) * C_GROUP)
        hi = cs[:, POOL_BUF + 1:POOL_BUF + 1 + L, sl]
        lo = cs[:, POOL_BUF + 1 - w:POOL_BUF + 1 - w + L, sl]
        cnt = jnp.minimum(pos + 1, w).astype(jnp.float32)[None, :, None]
        outs.append((hi - lo) / cnt)
    return jnp.concatenate(outs, axis=-1).astype(p_ext.dtype)


def mixer(h, conv_buf, pool_buf, start_pos, w_in, w_s, b_s, ln_g, ln_b, w_conv, w_pool,
          pool_scale, w_a_out, w_b_out, w_c_out, w_o):
    bn, L, _ = h.shape
    u, v, xb, gb, gc, p, gates = jnp.split(h @ w_in, SPLITS, axis=-1)
    u = jax.nn.gelu(u)
    v = layer_norm(jax.nn.gelu(v), ln_g, ln_b)
    y_a = chunk_spatial_gate(u, v, w_s, b_s) @ w_a_out
    z_ext = jnp.concatenate([conv_buf, gc * xb], axis=1)
    y_b = (gb * short_conv(z_ext, w_conv, L)) @ w_b_out
    p_ext = jnp.concatenate([pool_buf, p], axis=1)
    d = (multi_pool(p_ext, start_pos, L) - p).reshape(bn, L, N_C_GROUPS, C_GROUP)
    d = jnp.einsum('blgc,gcd->blgd', d, w_pool).reshape(bn, L, D_C) * pool_scale
    y_c = d @ w_c_out
    g_a, g_b, g_c = jnp.split(jax.nn.sigmoid(gates), N_BRANCH, axis=-1)
    out = (g_a * y_a + g_b * y_b + g_c * y_c) @ w_o
    return out, z_ext[:, -(CONV_W - 1):], p_ext[:, -POOL_BUF:], v


def run_trunk(x, conv_bufs, pool_bufs, start_pos, norm_g, w_ffn_gu, w_ffn_down, w_in, w_s, b_s,
              ln_g, ln_b, w_conv, w_pool, pool_scale, w_a_out, w_b_out, w_c_out, w_o):
    new_conv, new_pool, new_v = [], [], []
    for l in range(DEPTH):
        g = norm_g[l]
        x = x + 0.5 * rms_norm(swiglu(rms_norm(x, g[0]), w_ffn_gu[l, 0], w_ffn_down[l, 0]), g[1])
        m, cb, pb, v = mixer(rms_norm(x, g[2]), conv_bufs[l], pool_bufs[l], start_pos, w_in[l],
                             w_s[l], b_s[l], ln_g[l], ln_b[l], w_conv[l], w_pool[l], pool_scale[l],
                             w_a_out[l], w_b_out[l], w_c_out[l], w_o[l])
        x = x + rms_norm(m, g[3])
        x = x + 0.5 * rms_norm(swiglu(rms_norm(x, g[4]), w_ffn_gu[l, 1], w_ffn_down[l, 1]), g[5])
        new_conv.append(cb)
        new_pool.append(pb)
        new_v.append(v)
    return x, jnp.stack(new_conv), jnp.stack(new_pool), jnp.stack(new_v)


def setup_inputs(seed: int = 0) -> dict:
    key = jax.random.key(seed)
    ks = jax.random.split(key, 20)
    nrm = lambda k, shape, fan_in: jax.random.normal(k, shape, jnp.float32) * (fan_in ** -0.5)
    return {
        "x_prompt": jax.random.normal(ks[0], (BATCH, SEQ, D_MODEL), jnp.float32),
        "x_sample": jax.random.normal(ks[1], (DEC_BATCH, DEC_SEQ, D_MODEL), jnp.float32),
        "state_conv": jax.random.normal(ks[2], (DEPTH, DEC_BATCH, CONV_W - 1, D_B), jnp.float32),
        "state_pool": jax.random.normal(ks[3], (DEPTH, DEC_BATCH, POOL_BUF, D_C), jnp.float32),
        "norm_g": 1.0 + 0.02 * jax.random.normal(ks[4], (DEPTH, 6, D_MODEL), jnp.float32),
        "w_ffn_gu": nrm(ks[5], (DEPTH, 2, D_MODEL, 2 * D_FF), D_MODEL),
        "w_ffn_down": nrm(ks[6], (DEPTH, 2, D_FF, D_MODEL), D_FF),
        "w_in": nrm(ks[7], (DEPTH, D_MODEL, D_IN), D_MODEL),
        "w_s": nrm(ks[8], (DEPTH, N_A_GROUPS, CHUNK, CHUNK), CHUNK),
        "b_s": 1.0 + 0.02 * jax.random.normal(ks[9], (DEPTH, N_A_GROUPS, CHUNK), jnp.float32),
        "ln_g": 1.0 + 0.02 * jax.random.normal(ks[10], (DEPTH, D_A), jnp.float32),
        "ln_b": 0.02 * jax.random.normal(ks[11], (DEPTH, D_A), jnp.float32),
        "w_conv": nrm(ks[12], (DEPTH, CONV_W, D_B), CONV_W),
        "w_pool": nrm(ks[13], (DEPTH, N_C_GROUPS, C_GROUP, C_GROUP), C_GROUP),
        "pool_scale": 1.0 + 0.02 * jax.random.normal(ks[14], (DEPTH, D_C), jnp.float32),
        "w_a_out": nrm(ks[15], (DEPTH, D_A, D_MODEL), D_A),
        "w_b_out": nrm(ks[16], (DEPTH, D_B, D_MODEL), D_B),
        "w_c_out": nrm(ks[17], (DEPTH, D_C, D_MODEL), D_C),
        "w_o": nrm(ks[18], (DEPTH, D_MODEL, D_MODEL), D_MODEL),
    }


def reference(x_prompt, x_sample, state_conv, state_pool, norm_g, w_ffn_gu, w_ffn_down, w_in, w_s,
              b_s, ln_g, ln_b, w_conv, w_pool, pool_scale, w_a_out, w_b_out, w_c_out, w_o):
    zero_conv = jnp.zeros((DEPTH, x_prompt.shape[0], CONV_W - 1, D_B), x_prompt.dtype)
    zero_pool = jnp.zeros((DEPTH, x_prompt.shape[0], POOL_BUF, D_C), x_prompt.dtype)
    y_prompt, new_conv_prompt, new_pool_prompt, _ = run_trunk(
        x_prompt, zero_conv, zero_pool, 0, norm_g, w_ffn_gu, w_ffn_down, w_in, w_s, b_s, ln_g, ln_b,
        w_conv, w_pool, pool_scale, w_a_out, w_b_out, w_c_out, w_o)
    y_sample, new_conv_sample, new_pool_sample, new_chunk_v_sample = run_trunk(
        x_sample, state_conv.astype(x_sample.dtype), state_pool.astype(x_sample.dtype), PAST_LEN,
        norm_g, w_ffn_gu, w_ffn_down, w_in, w_s, b_s, ln_g, ln_b, w_conv, w_pool, pool_scale,
        w_a_out, w_b_out, w_c_out, w_o)
    return (y_prompt, y_sample, new_conv_prompt, new_pool_prompt, new_conv_sample, new_pool_sample, new_chunk_v_sample)
```

```cpp
#include <hip/hip_runtime.h>
#include <hip/hip_cooperative_groups.h>
#include <cstdio>
#include <cstdint>
namespace cg = cooperative_groups;

#ifndef MK_COOP
#define MK_COOP 1
#endif

#define LAS __attribute__((address_space(3)))
typedef unsigned short bf16_t;
typedef short bf16x8 __attribute__((ext_vector_type(8)));
typedef float f32x4 __attribute__((ext_vector_type(4)));
typedef unsigned u32x4 __attribute__((ext_vector_type(4)));

constexpr int TP = 16384, TS = 512, T = TP + TS, D = 1024, FF = 2816, DIN = 6144, DEPTH = 4;
constexpr int PAST_T = 2048;
constexpr float EPS = 1e-6f;
constexpr int NTHREADS = 512, NWAVES = 8;
constexpr int RING_BYTES = 131072, LDS_BYTES = 147456;

constexpr size_t SZ_WGU = (size_t)5632 * 1024 * 2, SZ_WDN = (size_t)1024 * 2816 * 2, SZ_WIN = (size_t)6144 * 1024 * 2, SZ_WBR = (size_t)1024 * 512 * 2, SZ_WO = (size_t)1024 * 1024 * 2;
constexpr size_t WS_WGU = 0;
constexpr size_t WS_WDN = WS_WGU + 8 * SZ_WGU;
constexpr size_t WS_WIN = WS_WDN + 8 * SZ_WDN;
constexpr size_t WS_WA = WS_WIN + 4 * SZ_WIN;
constexpr size_t WS_WB = WS_WA + 4 * SZ_WBR;
constexpr size_t WS_WC = WS_WB + 4 * SZ_WBR;
constexpr size_t WS_WO = WS_WC + 4 * SZ_WBR;
constexpr size_t WS_H = WS_WO + 4 * SZ_WO;
constexpr size_t WS_M = WS_H + (size_t)T * D * 2;
constexpr size_t WS_MIX = WS_M + (size_t)T * D * 4;
constexpr size_t WS_AIN = WS_MIX + (size_t)T * DIN * 2;
constexpr size_t WS_BIN = WS_AIN + (size_t)T * 512 * 2;
constexpr size_t WS_CIN = WS_BIN + (size_t)T * 512 * 2;
constexpr size_t WS_MG = WS_CIN + (size_t)T * 512 * 2;
constexpr size_t WS_P = WS_MG + (size_t)T * D * 2;
constexpr size_t WS_MGP = WS_P + (size_t)11 * TS * D * 4;
constexpr size_t WS_RS = WS_MGP + (size_t)2 * TS * D * 2;
constexpr size_t WS_CTL = WS_RS + (size_t)T * 4 + 256;
constexpr size_t CTL_SN = 16384 + 12 * 64 * 2 * 64;
constexpr size_t CTL_BYTES = CTL_SN + 12 * 256;
constexpr size_t WS_X1 = WS_CTL + CTL_BYTES;
constexpr size_t WS_X2 = WS_X1 + (size_t)64 * 256 * 4 * 4;
constexpr size_t WS_END = WS_X2 + (size_t)64 * 256 * 4 * 4;
static_assert(WS_CIN - WS_BIN == WS_BIN - WS_AIN && WS_WC - WS_WB == WS_WB - WS_WA, "branch operand spacing");

constexpr size_t O_Y = 0;
constexpr size_t O_CONV_P = (size_t)T * D;
constexpr size_t O_POOL_P = O_CONV_P + (size_t)DEPTH * 8 * 2 * 512;
constexpr size_t O_CONV_S = O_POOL_P + (size_t)DEPTH * 8 * 15 * 512;
constexpr size_t O_POOL_S = O_CONV_S + (size_t)DEPTH * 128 * 2 * 512;
constexpr size_t O_V_S = O_POOL_S + (size_t)DEPTH * 128 * 15 * 512;
constexpr size_t O_END = O_V_S + (size_t)DEPTH * 128 * 4 * 512;

struct Params {
    const float *xp, *xs, *sconv, *spool, *ng, *wgu, *wdn, *win, *wsp, *bs, *lng, *lnb, *wconv, *wpool, *pscale, *wa, *wb, *wc, *wo;
    float* out; unsigned char* ws; int ph_lo, ph_hi;
};

__device__ __forceinline__ unsigned cvt_pk_bf16(float lo, float hi) { unsigned r; asm("v_cvt_pk_bf16_f32 %0, %1, %2" : "=v"(r) : "v"(lo), "v"(hi)); return r; }
__device__ __forceinline__ float bf_lo(unsigned w) { return __uint_as_float(w << 16); }
__device__ __forceinline__ float bf_hi(unsigned w) { return __uint_as_float(w & 0xffff0000u); }
__device__ __forceinline__ void unpack8(const u32x4 w, float (&f)[8]) { f[0] = bf_lo(w.x); f[1] = bf_hi(w.x); f[2] = bf_lo(w.y); f[3] = bf_hi(w.y); f[4] = bf_lo(w.z); f[5] = bf_hi(w.z); f[6] = bf_lo(w.w); f[7] = bf_hi(w.w); }
__device__ __forceinline__ u32x4 pack8(const float (&f)[8]) { u32x4 w; w.x = cvt_pk_bf16(f[0], f[1]); w.y = cvt_pk_bf16(f[2], f[3]); w.z = cvt_pk_bf16(f[4], f[5]); w.w = cvt_pk_bf16(f[6], f[7]); return w; }
__device__ __forceinline__ void load8f(const float* p, float (&f)[8]) { const f32x4 a = *(const f32x4*)p, b = *(const f32x4*)(p + 4); f[0] = a[0]; f[1] = a[1]; f[2] = a[2]; f[3] = a[3]; f[4] = b[0]; f[5] = b[1]; f[6] = b[2]; f[7] = b[3]; }
__device__ __forceinline__ void store8f(float* p, const float (&f)[8]) { *(f32x4*)p = (f32x4){f[0], f[1], f[2], f[3]}; *(f32x4*)(p + 4) = (f32x4){f[4], f[5], f[6], f[7]}; }
__device__ __forceinline__ void load8bf(const bf16_t* p, float (&f)[8]) { unpack8(*(const u32x4*)p, f); }
__device__ __forceinline__ float fsigmoid(float x) { return __builtin_amdgcn_rcpf(1.0f + __builtin_amdgcn_exp2f(-1.44269504089f * x)); }
__device__ __forceinline__ float fsilu(float x) { return x * fsigmoid(x); }
__device__ __forceinline__ float fgelu(float x) { const float u = x * (1.0f + 0.044715f * x * x); return x * fsigmoid(1.5957691216f * u); }
template <int CTRL> __device__ __forceinline__ float dpp_mov(float x) { return __builtin_bit_cast(float, __builtin_amdgcn_mov_dpp(__builtin_bit_cast(int, x), CTRL, 0xf, 0xf, true)); }
__device__ __forceinline__ float wave_sum(float x) {
    x += dpp_mov<0xB1>(x);
    x += dpp_mov<0x4E>(x);
    x += dpp_mov<0x141>(x);
    x += dpp_mov<0x128>(x);
    auto s = __builtin_amdgcn_permlane16_swap(__float_as_uint(x), __float_as_uint(x), false, false);
    x = __uint_as_float(s[0]) + __uint_as_float(s[1]);
    auto t = __builtin_amdgcn_permlane32_swap(__float_as_uint(x), __float_as_uint(x), false, false);
    return __uint_as_float(t[0]) + __uint_as_float(t[1]);
}

constexpr int BM = 256, BK = 64, HALF = 128, HTB = HALF * BK * 2, NXCD = 8, WGM = 8;
__device__ __forceinline__ int lds_byte(int r, int c) { const int st = (r >> 4) * 2 + (c >> 5), rr = r & 15, cc = c & 31, ob = rr * 64 + cc * 2; return st * 1024 + (ob ^ (((ob >> 9) & 1) << 5)); }
__device__ __forceinline__ void stage_rc(int b, int& R, int& C) { const int st = b / 1024, sb = b % 1024, swz = sb ^ (((sb >> 9) & 1) << 5); R = (st >> 1) * 16 + swz / 64; C = (st & 1) * 32 + (swz % 64) / 2; }
__device__ __forceinline__ int perm32(int rho) { const int n = rho >> 4, i = rho & 15; return 8 * (i >> 2) + 4 * n + (i & 3); }

struct Unit { const char* A; const char* B; int pm, pn, sub, sp, nt; };

struct Sched {
    int nM, nN, nwg, G, c, nsub, nt; const char *A0, *B0; size_t dA, dB, tstep;
    int xS, xnt, xKS; const char* xA0; size_t xAp;
    const unsigned* ready; unsigned need;
    int xfirst;
    __device__ __forceinline__ bool next(int i, Unit& u) const {
        int tile = i / nsub; const int sub = i - tile * nsub;
        if (xfirst) { const bool hasx = c < 8 * xS; if (i > (hasx ? 1 : 0)) return false; tile = hasx ? 1 - i : 0; }
        const long L = (long)tile * G + c;
        if (L >= nwg) {
            const int e = (int)(L - nwg); if (e >= 8 * xS) return false;
            const int xt = e / xS, sp = e - xt * xS;
            u.pm = 64 + (xt >> 2); u.pn = xt & 3; u.sub = sub; u.sp = sp; u.nt = xnt;
            const int part = sp / xKS, ksp = sp - part * xKS;
            u.A = xA0 + (size_t)sub * dA + (size_t)part * xAp + (size_t)(xt >> 2) * tstep + (size_t)ksp * xnt * (BK * 2); u.B = B0 + (size_t)sub * dB + (size_t)u.pn * tstep + (size_t)ksp * xnt * (BK * 2);
            return true;
        }
        int wgid = (int)L; { const int q = nwg / NXCD, r = nwg % NXCD, xcd = wgid % NXCD, off = wgid / NXCD; wgid = (xcd < r ? xcd * (q + 1) : r * (q + 1) + (xcd - r) * q) + off; }
        const int nig = WGM * nN, gid = wgid / nig, fm = gid * WGM, gsz = (nM - fm) < WGM ? (nM - fm) : WGM;
        u.pm = fm + ((wgid % nig) % gsz); u.pn = (wgid % nig) / gsz; u.sub = sub; u.sp = 0; u.nt = nt;
        u.A = A0 + (size_t)sub * dA + (size_t)u.pm * tstep; u.B = B0 + (size_t)sub * dB + (size_t)u.pn * tstep;
        return true;
    }
    __device__ __forceinline__ void a_ready(const Unit& u) const {
        if (ready == nullptr || u.pm < 64 || u.sub != 0) return;
        if (threadIdx.x < 64) { unsigned sp_ = 0;
            while ((unsigned)__builtin_amdgcn_readfirstlane(__hip_atomic_load(ready, __ATOMIC_RELAXED, __HIP_MEMORY_SCOPE_AGENT)) < need) { __builtin_amdgcn_s_sleep(2); if (++sp_ > (1u << 22)) break; }
            __builtin_amdgcn_fence(__ATOMIC_ACQUIRE, "agent");
            asm volatile("s_waitcnt vmcnt(0)" ::: "memory"); }
        asm volatile("" ::: "memory"); __builtin_amdgcn_s_barrier(); asm volatile("" ::: "memory");
    }
};

#define ZERO_ACC() do { _Pragma("unroll") for (int a_ = 0; a_ < 2; ++a_) _Pragma("unroll") for (int b_ = 0; b_ < 2; ++b_) _Pragma("unroll") for (int m_ = 0; m_ < 4; ++m_) _Pragma("unroll") for (int n_ = 0; n_ < 2; ++n_) acc[a_][b_][m_][n_] = (f32x4){0.f, 0.f, 0.f, 0.f}; } while (0)

struct EpiSwiGLU {
    static constexpr bool PERM = true, FUSED = false;
    bf16_t* O; const float* RS;
    __device__ __forceinline__ void operator()(f32x4 (&acc)[2][2][4][2], const Unit& u, int wr, int wc, int fr, int fq) const {
        const int row0 = u.pm * BM + wr * 64 + fr, col0 = u.pn * 128 + wc * 32 + 8 * fq;
#pragma unroll
        for (int ai = 0; ai < 2; ++ai)
#pragma unroll
            for (int m = 0; m < 4; ++m) {
                const float rs = RS[row0 + ai * HALF + m * 16];
                u32x4 w;
                {
                    typedef float f32x2 __attribute__((ext_vector_type(2)));
                    unsigned wv[4];
#pragma unroll
                    for (int h = 0; h < 4; ++h) {
                        const f32x4 ga = acc[ai][0][m][h >> 1], ua = acc[ai][1][m][h >> 1];
                        const f32x2 g2 = (f32x2){ga[(h & 1) * 2], ga[(h & 1) * 2 + 1]} * rs, u2 = (f32x2){ua[(h & 1) * 2], ua[(h & 1) * 2 + 1]} * rs;
                        const f32x2 t2 = g2 * u2, a2 = g2 * (-1.44269504089f);
                        f32x2 e2; e2.x = __builtin_amdgcn_exp2f(a2.x); e2.y = __builtin_amdgcn_exp2f(a2.y);
                        const f32x2 d2 = e2 + 1.0f;
                        f32x2 r2; r2.x = __builtin_amdgcn_rcpf(d2.x); r2.y = __builtin_amdgcn_rcpf(d2.y);
                        const f32x2 o2 = t2 * r2;
                        wv[h] = cvt_pk_bf16(o2.x, o2.y); }
                    w.x = wv[0]; w.y = wv[1]; w.z = wv[2]; w.w = wv[3];
                }
                *(u32x4*)(O + (size_t)(row0 + ai * HALF + m * 16) * FF + col0) = w;
            }
        ZERO_ACC();
    }
};
struct EpiM {
    static constexpr bool PERM = true, FUSED = true;
    float* P; bf16_t* XB; float* RS; float* OUT; const float* gpost; float cpost; float* X1; float* X2; unsigned* cnt1; unsigned* cnt2; int final_out;
    __device__ __forceinline__ void operator()(f32x4 (&acc)[2][2][4][2], const Unit& u, int wr, int wc, int fr, int fq) const {
        const int row0 = u.pm * BM + wr * 64 + fr, col0 = u.pn * BM + wc * 32 + 8 * fq;
        float* base = P + (size_t)u.sp * TS * D - (size_t)TP * D;
#pragma unroll
        for (int ai = 0; ai < 2; ++ai)
#pragma unroll
            for (int m = 0; m < 4; ++m) { float* rowp = base + (size_t)(row0 + ai * HALF + m * 16) * D + col0;
#pragma unroll
                for (int bj = 0; bj < 2; ++bj) { *(f32x4*)(rowp + bj * HALF) = acc[ai][bj][m][0]; *(f32x4*)(rowp + bj * HALF + 4) = acc[ai][bj][m][1]; } }
        ZERO_ACC();
    }
    __device__ __forceinline__ void row_sumsq(const f32x4 (&acc)[2][2][4][2], const Unit& u, int wr, int wc, int fr, int fq, LAS unsigned char* lds, float* X, unsigned* cnt) const {
        LAS float* Pt = (LAS float*)lds;
        LAS float* S = (LAS float*)(lds + 4096);
#pragma unroll
        for (int ai = 0; ai < 2; ++ai)
#pragma unroll
            for (int m = 0; m < 4; ++m) { float q = 0.f;
#pragma unroll
                for (int bj = 0; bj < 2; ++bj)
#pragma unroll
                    for (int n = 0; n < 2; ++n) { const f32x4 x = acc[ai][bj][m][n]; q += (x[0] * x[0] + x[1] * x[1]) + (x[2] * x[2] + x[3] * x[3]); }
                q += __shfl_xor(q, 16); q += __shfl_xor(q, 32);
                if (fq == 0) Pt[(ai * HALF + wr * 64 + m * 16 + fr) * 4 + wc] = q; }
        asm volatile("s_waitcnt lgkmcnt(0)" ::: "memory"); __builtin_amdgcn_s_barrier(); asm volatile("" ::: "memory");
        const int t = threadIdx.x;
        if (t < 256) { const float tot = (Pt[t * 4 + 0] + Pt[t * 4 + 1]) + (Pt[t * 4 + 2] + Pt[t * 4 + 3]);
            __hip_atomic_store(X + ((size_t)(u.pm * BM + t) * 4 + u.pn), tot, __ATOMIC_RELAXED, __HIP_MEMORY_SCOPE_AGENT); }
        asm volatile("s_waitcnt vmcnt(0)" ::: "memory");
        if (t < 256 && (t & 63) == 0) __hip_atomic_fetch_add(cnt, 1u, __ATOMIC_RELAXED, __HIP_MEMORY_SCOPE_AGENT);
        if (t < 64) { unsigned sp_ = 0;
            while ((unsigned)__builtin_amdgcn_readfirstlane(__hip_atomic_load(cnt, __ATOMIC_RELAXED, __HIP_MEMORY_SCOPE_AGENT)) < 16u) { __builtin_amdgcn_s_sleep(1); if (++sp_ > (1u << 22)) break; } }
        asm volatile("s_waitcnt vmcnt(0) lgkmcnt(0)" ::: "memory"); __builtin_amdgcn_s_barrier(); asm volatile("" ::: "memory");
        if (t < 256) { const float* xs = X + (size_t)(u.pm * BM + t) * 4; float tot = 0.f;
#pragma unroll
            for (int k = 0; k < 4; ++k) tot += __hip_atomic_load(xs + k, __ATOMIC_RELAXED, __HIP_MEMORY_SCOPE_AGENT);
            S[t] = tot; }
        asm volatile("s_waitcnt vmcnt(0) lgkmcnt(0)" ::: "memory"); __builtin_amdgcn_s_barrier(); asm volatile("" ::: "memory");
    }
    __device__ __forceinline__ void fused(f32x4 (&acc)[2][2][4][2], const Unit& u, int wr, int wc, int fr, int fq, LAS unsigned char* lds) const {
        const LAS float* S = (const LAS float*)(lds + 4096);
        const int col0 = u.pn * BM + wc * 32 + 8 * fq;
        unsigned* c1 = cnt1 + 16 * u.pm; unsigned* c2 = cnt2 + 16 * u.pm;
        row_sumsq(acc, u, wr, wc, fr, fq, lds, X1, c1);
        float g8[2][8]; load8f(gpost + col0, g8[0]); load8f(gpost + col0 + HALF, g8[1]);
#pragma unroll
        for (int ai = 0; ai < 2; ++ai)
#pragma unroll
            for (int m = 0; m < 4; ++m) { const int r = ai * HALF + wr * 64 + m * 16 + fr; const float rs = cpost * rsqrtf(S[r] * (1.0f / D) + EPS);
#pragma unroll
                for (int bj = 0; bj < 2; ++bj) { float xb[8]; load8bf(XB + (size_t)(u.pm * BM + r) * D + col0 + bj * HALF, xb);
#pragma unroll
                    for (int j = 0; j < 4; ++j) { acc[ai][bj][m][0][j] = xb[j] + acc[ai][bj][m][0][j] * rs * g8[bj][j]; acc[ai][bj][m][1][j] = xb[4 + j] + acc[ai][bj][m][1][j] * rs * g8[bj][4 + j]; } } }
        if (final_out) {
#pragma unroll
            for (int ai = 0; ai < 2; ++ai)
#pragma unroll
                for (int m = 0; m < 4; ++m) { float* rowp = OUT + (size_t)(u.pm * BM + ai * HALF + wr * 64 + m * 16 + fr) * D + col0;
#pragma unroll
                    for (int bj = 0; bj < 2; ++bj) { *(f32x4*)(rowp + bj * HALF) = acc[ai][bj][m][0]; *(f32x4*)(rowp + bj * HALF + 4) = acc[ai][bj][m][1]; } }
            return;
        }
        asm volatile("s_waitcnt lgkmcnt(0)" ::: "memory"); __builtin_amdgcn_s_barrier(); asm volatile("" ::: "memory");
        row_sumsq(acc, u, wr, wc, fr, fq, lds, X2, c2);
        if (u.pn == 0 && threadIdx.x < 256) RS[u.pm * BM + threadIdx.x] = rsqrtf(S[threadIdx.x] * (1.0f / D) + EPS);
#pragma unroll
        for (int ai = 0; ai < 2; ++ai)
#pragma unroll
            for (int m = 0; m < 4; ++m) { bf16_t* rowp = XB + (size_t)(u.pm * BM + ai * HALF + wr * 64 + m * 16 + fr) * D + col0;
#pragma unroll
                for (int bj = 0; bj < 2; ++bj) { const f32x4 v0 = acc[ai][bj][m][0], v1 = acc[ai][bj][m][1];
                    u32x4 w; w.x = cvt_pk_bf16(v0[0], v0[1]); w.y = cvt_pk_bf16(v0[2], v0[3]); w.z = cvt_pk_bf16(v1[0], v1[1]); w.w = cvt_pk_bf16(v1[2], v1[3]);
                    *(u32x4*)(rowp + bj * HALF) = w; } }
    }
};
struct EpiMix {
    static constexpr bool PERM = true, FUSED = false;
    bf16_t* O; const float* RS;
    __device__ __forceinline__ void operator()(f32x4 (&acc)[2][2][4][2], const Unit& u, int wr, int wc, int fr, int fq) const {
        const int row0 = u.pm * BM + wr * 64 + fr, col0 = u.pn * BM + wc * 32 + 8 * fq;
        const int kind = u.pn < 4 ? 0 : (u.pn < 12 ? 1 : 2);
#pragma unroll
        for (int ai = 0; ai < 2; ++ai)
#pragma unroll
            for (int m = 0; m < 4; ++m) { bf16_t* rowp = O + (size_t)(row0 + ai * HALF + m * 16) * DIN + col0; const float rs = RS[row0 + ai * HALF + m * 16];
#pragma unroll
                for (int bj = 0; bj < 2; ++bj) { f32x4 v0 = acc[ai][bj][m][0] * rs, v1 = acc[ai][bj][m][1] * rs;
                    if (kind == 0) {
#pragma unroll
                        for (int j = 0; j < 4; ++j) { v0[j] = fgelu(v0[j]); v1[j] = fgelu(v1[j]); } }
                    else if (kind == 2) {
#pragma unroll
                        for (int j = 0; j < 4; ++j) { v0[j] = fsigmoid(v0[j]); v1[j] = fsigmoid(v1[j]); } }
                    u32x4 w; w.x = cvt_pk_bf16(v0[0], v0[1]); w.y = cvt_pk_bf16(v0[2], v0[3]); w.z = cvt_pk_bf16(v1[0], v1[1]); w.w = cvt_pk_bf16(v1[2], v1[3]);
                    *(u32x4*)(rowp + bj * HALF) = w; } }
        ZERO_ACC();
    }
};
struct EpiBranch {
    static constexpr bool PERM = true, FUSED = false;
    const bf16_t* G;
    bf16_t* O;
    bf16_t* O2;
    __device__ __forceinline__ void operator()(f32x4 (&acc)[2][2][4][2], const Unit& u, int wr, int wc, int fr, int fq) const {
        const int row0 = u.pm * BM + wr * 64 + fr, col0 = u.pn * BM + wc * 32 + 8 * fq;
        const int sub = u.sub;
#pragma unroll
        for (int ai = 0; ai < 2; ++ai)
#pragma unroll
            for (int m = 0; m < 4; ++m) { const size_t row = (size_t)(row0 + ai * HALF + m * 16);
#pragma unroll
                for (int bj = 0; bj < 2; ++bj) {
                    const bf16_t* gp = G + row * DIN + col0 + bj * HALF;
                    if (sub < 2) {
                        float gn[8], gd[8]; load8bf(gp + sub * D, gn); load8bf(gp + (sub + 1) * D, gd);
#pragma unroll
                        for (int j = 0; j < 4; ++j) { acc[ai][bj][m][0][j] *= gn[j] * __builtin_amdgcn_rcpf(fmaxf(gd[j], 1e-30f)); acc[ai][bj][m][1][j] *= gn[4 + j] * __builtin_amdgcn_rcpf(fmaxf(gd[4 + j], 1e-30f)); }
                    } else {
                        float gn[8]; load8bf(gp + 2 * D, gn);
                        const f32x4 v0 = acc[ai][bj][m][0], v1 = acc[ai][bj][m][1];
                        u32x4 w; w.x = cvt_pk_bf16(v0[0] * gn[0], v0[1] * gn[1]); w.y = cvt_pk_bf16(v0[2] * gn[2], v0[3] * gn[3]); w.z = cvt_pk_bf16(v1[0] * gn[4], v1[1] * gn[5]); w.w = cvt_pk_bf16(v1[2] * gn[6], v1[3] * gn[7]);
                        if (u.pm < 64) *(u32x4*)(O + row * D + col0 + bj * HALF) = w;
                        else *(u32x4*)(O2 + (size_t)u.sp * TS * D + (row - TP) * D + col0 + bj * HALF) = w;
                        acc[ai][bj][m][0] = (f32x4){0.f, 0.f, 0.f, 0.f}; acc[ai][bj][m][1] = (f32x4){0.f, 0.f, 0.f, 0.f};
                    } } }
    }
};

template <class Epi>
__device__ __forceinline__ void gemm_phase(LAS unsigned char* lds, const int K, const Sched& S, const Epi& E) {
    int tid_ = threadIdx.x; asm volatile("" : "+v"(tid_));
    const int tid = tid_, wid = __builtin_amdgcn_readfirstlane(tid >> 6), lane = tid & 63, wr = wid >> 2, wc = wid & 3, fr = lane & 15, fq = lane >> 4;
    unsigned voffA[2], voffB[2];
#pragma unroll
    for (int i = 0; i < 2; ++i) { int R, C; stage_rc(tid * 16 + i * 8192, R, C); const int Rb = Epi::PERM ? ((R & ~31) + perm32(R & 31)) : R;
        voffA[i] = (unsigned)(R * K + C) * 2u; voffB[i] = (unsigned)(Rb * K + C) * 2u; }
    const size_t kstep = (size_t)(BK * 2);
    const size_t hstep = (size_t)HALF * K * 2;
    const unsigned ldsw = (unsigned)wid * 1024u;
    const int aoff = lds_byte(wr * 64 + fr, fq * 8), boff = lds_byte(wc * 32 + fr, fq * 8);
#define PG8_SA(b, h) (((b) * 2 + (h)) * HTB)
#define PG8_SB(b, h) ((4 + (b) * 2 + (h)) * HTB)
#define PG8_STAGE(bufoff, gbase, voff) do { _Pragma("unroll") for (int _i = 0; _i < 2; ++_i) \
        __builtin_amdgcn_global_load_lds((const unsigned*)((const char*)(gbase) + (voff)[_i]), (LAS unsigned*)(lds + (bufoff) + ldsw + _i * 8192), 16, 0, 0); } while (0)
#define PG8_LDA(dst, b, h) do { _Pragma("unroll") for (int m = 0; m < 4; ++m) _Pragma("unroll") for (int k = 0; k < 2; ++k) dst[m][k] = *(const LAS bf16x8*)(lds + PG8_SA(b, h) + aoff + m * 2048 + k * 1024); } while (0)
#define PG8_LDB(dst, b, h) do { _Pragma("unroll") for (int n = 0; n < 2; ++n) _Pragma("unroll") for (int k = 0; k < 2; ++k) dst[n][k] = *(const LAS bf16x8*)(lds + PG8_SB(b, h) + boff + n * 2048 + k * 1024); } while (0)
#define PG8_MMA(ai, bj, At, Bt) do { __builtin_amdgcn_s_setprio(1); _Pragma("unroll") for (int m = 0; m < 4; ++m) _Pragma("unroll") for (int n = 0; n < 2; ++n) _Pragma("unroll") for (int k = 0; k < 2; ++k) \
        acc[ai][bj][m][n] = __builtin_amdgcn_mfma_f32_16x16x32_bf16(Bt[n][k], At[m][k], acc[ai][bj][m][n], 0, 0, 0); __builtin_amdgcn_s_setprio(0); } while (0)
#define PG8_WAIT_V(n) asm volatile("s_waitcnt vmcnt(" #n ")" ::: "memory")
#define PG8_WAIT_L(n) asm volatile("s_waitcnt lgkmcnt(" #n ")" ::: "memory")
#define PG8_BAR __builtin_amdgcn_s_barrier()
#define PG8_SCHED __builtin_amdgcn_sched_barrier(0)
    Unit cur, nxt; int ui = 0;
    if (!S.next(0, cur)) return;
    f32x4 acc[2][2][4][2];
    ZERO_ACC();
    bf16x8 At[4][2], B0[2][2], B1[2][2];
    const char* cA = cur.A; const char* cB = cur.B;
    S.a_ready(cur);
    PG8_STAGE(PG8_SB(0, 0), cB, voffB); PG8_STAGE(PG8_SB(0, 1), cB + hstep, voffB); PG8_STAGE(PG8_SA(0, 0), cA, voffA); PG8_STAGE(PG8_SA(0, 1), cA + hstep, voffA);
    PG8_STAGE(PG8_SB(1, 0), cB + kstep, voffB); PG8_STAGE(PG8_SA(1, 0), cA + kstep, voffA); PG8_STAGE(PG8_SB(1, 1), cB + hstep + kstep, voffB);
    if (wr == 1) PG8_BAR;
    PG8_WAIT_V(8); PG8_BAR;
    PG8_WAIT_V(6); PG8_BAR;
    for (;;) {
        const bool has_next = S.next(ui + 1, nxt);
        const char* nA = has_next ? nxt.A : cA; const char* nB = has_next ? nxt.B : cB;
        const int nt = cur.nt;
        for (int t = 0; t < nt; t += 2) {
            const bool last = (t == nt - 2);
            const char* a1 = cA + (size_t)(t + 1) * kstep;
            const char* a2 = last ? nA : cA + (size_t)(t + 2) * kstep; const char* b2 = last ? nB : cB + (size_t)(t + 2) * kstep;
            const char* a3 = a2 + kstep; const char* b3 = b2 + kstep;
            if (last && has_next) S.a_ready(nxt);
            PG8_LDB(B0, 0, 0); PG8_LDB(B1, 0, 1); PG8_SCHED; PG8_LDA(At, 0, 0); PG8_STAGE(PG8_SA(1, 1), a1 + hstep, voffA);
            PG8_WAIT_V(8); PG8_WAIT_L(0); PG8_BAR; PG8_MMA(0, 0, At, B0); PG8_MMA(0, 1, At, B1); PG8_BAR; PG8_SCHED;
            PG8_LDA(At, 0, 1); PG8_STAGE(PG8_SB(0, 0), b2, voffB); PG8_STAGE(PG8_SB(0, 1), b2 + hstep, voffB); PG8_STAGE(PG8_SA(0, 0), a2, voffA);
            PG8_WAIT_V(8); PG8_WAIT_L(0); PG8_BAR; PG8_MMA(1, 0, At, B0); PG8_MMA(1, 1, At, B1); PG8_BAR; PG8_SCHED;
            PG8_LDB(B0, 1, 0); PG8_LDB(B1, 1, 1); PG8_SCHED; PG8_LDA(At, 1, 0); PG8_STAGE(PG8_SA(0, 1), a2 + hstep, voffA);
            PG8_WAIT_V(8); PG8_WAIT_L(0); PG8_BAR; PG8_MMA(0, 0, At, B0); PG8_MMA(0, 1, At, B1); PG8_BAR; PG8_SCHED;
            PG8_LDA(At, 1, 1); PG8_STAGE(PG8_SB(1, 0), b3, voffB); PG8_STAGE(PG8_SB(1, 1), b3 + hstep, voffB); PG8_STAGE(PG8_SA(1, 0), a3, voffA);
            PG8_WAIT_V(8); PG8_WAIT_L(0); PG8_BAR; PG8_MMA(1, 0, At, B0); PG8_MMA(1, 1, At, B1); PG8_BAR; PG8_SCHED;
        }
        if (wr == 0) PG8_BAR;
        if (!(Epi::FUSED && !has_next)) E(acc, cur, wr, wc, fr, fq);
        if (!has_next) break;
        cur = nxt; cA = nA; cB = nB; ++ui;
        if (wr == 1) PG8_BAR;
    }
    PG8_WAIT_V(0);
    PG8_BAR;
    if constexpr (Epi::FUSED) E.fused(acc, cur, wr, wc, fr, fq, lds);
#undef PG8_SA
#undef PG8_SB
#undef PG8_STAGE
#undef PG8_LDA
#undef PG8_LDB
#undef PG8_MMA
#undef PG8_WAIT_V
#undef PG8_WAIT_L
#undef PG8_BAR
#undef PG8_SCHED
}

__device__ __forceinline__ void transpose_item(const float* W, int K, int N, bf16_t* WT, LAS float* scr, int item, int lane, bool gu_map, const float* gk) {
    const int nblk = N / 32, kb = item / nblk, nb = item % nblk, k0 = 64 * kb, n0 = 32 * nb;
    int s0 = n0;
    if (gu_map) { const int pn = n0 >> 8, w = n0 & 255; s0 = (w < 128) ? pn * 128 + w : FF + pn * 128 + (w - 128); }
    {
        f32x4 v[8]; float gg[8];
#pragma unroll
        for (int i = 0; i < 8; ++i) { const int kk = (lane >> 3) + 8 * i; v[i] = *(const f32x4*)(W + (size_t)(k0 + kk) * N + s0 + (lane & 7) * 4); gg[i] = gk ? gk[k0 + kk] : 1.0f; }
#pragma unroll
        for (int i = 0; i < 8; ++i) { const int kk = (lane >> 3) + 8 * i; LAS float* d = scr + kk * 33 + (lane & 7) * 4;
            d[0] = v[i][0] * gg[i]; d[1] = v[i][1] * gg[i]; d[2] = v[i][2] * gg[i]; d[3] = v[i][3] * gg[i]; }
    }
    asm volatile("s_waitcnt lgkmcnt(0)" ::: "memory");
    const int c = lane & 7;
#pragma unroll
    for (int j = 0; j < 4; ++j) { const int n = (lane >> 3) + 8 * j; const LAS float* s = scr + (8 * c) * 33 + n;
        u32x4 o; o.x = cvt_pk_bf16(s[0 * 33], s[1 * 33]); o.y = cvt_pk_bf16(s[2 * 33], s[3 * 33]); o.z = cvt_pk_bf16(s[4 * 33], s[5 * 33]); o.w = cvt_pk_bf16(s[6 * 33], s[7 * 33]);
        *(u32x4*)(WT + (size_t)(n0 + n) * K + k0 + 8 * c) = o; }
    asm volatile("s_waitcnt lgkmcnt(0)" ::: "memory");
}

constexpr int PREP_I_GU = 16 * 176, PREP_I_DN = 44 * 32, PREP_I_IN = 16 * 192, PREP_I_BR = 8 * 32, PREP_I_O = 16 * 32;
constexpr int PREP_PER_L = 2 * PREP_I_GU + 2 * PREP_I_DN + PREP_I_IN + 2 * PREP_I_BR + PREP_I_O;
__device__ __forceinline__ void prep_layer(const Params& p, int l, LAS unsigned char* lds, int wid, int lane, int worker, int n_workers, int it0, int it1) {
    LAS float* scr = (LAS float*)(lds + wid * 16384);
    for (int it = it0 + worker; it < it1; it += n_workers) {
        int r = it;
        if (r < 2 * PREP_I_GU) { const int j = r / PREP_I_GU; r -= j * PREP_I_GU;
            transpose_item(p.wgu + (size_t)(l * 2 + j) * D * 2 * FF, D, 2 * FF, (bf16_t*)(p.ws + WS_WGU + (size_t)(l * 2 + j) * SZ_WGU), scr, r, lane, true, p.ng + (size_t)(l * 6 + (j == 0 ? 0 : 4)) * D); continue; }
        r -= 2 * PREP_I_GU;
        if (r < 2 * PREP_I_DN) { const int j = r / PREP_I_DN; r -= j * PREP_I_DN;
            transpose_item(p.wdn + (size_t)(l * 2 + j) * FF * D, FF, D, (bf16_t*)(p.ws + WS_WDN + (size_t)(l * 2 + j) * SZ_WDN), scr, r, lane, false, nullptr); continue; }
        r -= 2 * PREP_I_DN;
        if (r < PREP_I_IN) { transpose_item(p.win + (size_t)l * D * DIN, D, DIN, (bf16_t*)(p.ws + WS_WIN + (size_t)l * SZ_WIN), scr, r, lane, false, p.ng + (size_t)(l * 6 + 2) * D); continue; }
        r -= PREP_I_IN;
        if (r < PREP_I_BR) { transpose_item(p.wa + (size_t)l * 512 * D, 512, D, (bf16_t*)(p.ws + WS_WA + (size_t)l * SZ_WBR), scr, r, lane, false, nullptr); continue; }
        r -= PREP_I_BR;
        if (r < PREP_I_BR) { transpose_item(p.wb + (size_t)l * 512 * D, 512, D, (bf16_t*)(p.ws + WS_WB + (size_t)l * SZ_WBR), scr, r, lane, false, nullptr); continue; }
        r -= PREP_I_BR;
        transpose_item(p.wo + (size_t)l * D * D, D, D, (bf16_t*)(p.ws + WS_WO + (size_t)l * SZ_WO), scr, r, lane, false, nullptr);
    }
}
constexpr int PREP_W1 = 1363, PREP_W2 = 6090, PREP_W3 = 11180;
__device__ __forceinline__ void fold_items(const Params& p, LAS unsigned char* lds, int tid, int it0, int it1, int worker_wg, int n_wg);
__device__ __forceinline__ void prep_window(const Params& p, int l, int w, LAS unsigned char* lds, int worker_wg, int n_wg) {
    int tid = threadIdx.x; asm volatile("" : "+v"(tid));
    const int wid = __builtin_amdgcn_readfirstlane(tid >> 6), lane = tid & 63;
    const int wk = worker_wg * NWAVES + wid, nw = n_wg * NWAVES;
    if (l + 1 < DEPTH) { const int i0 = w == 0 ? 0 : (w == 1 ? PREP_W1 : (w == 2 ? PREP_W2 : PREP_W3)), i1 = w == 0 ? PREP_W1 : (w == 1 ? PREP_W2 : (w == 2 ? PREP_W3 : PREP_PER_L));
        prep_layer(p, l + 1, lds, wid, lane, wk, nw, i0, i1); }
    if (l == 0 && w == 1) prep_layer(p, 0, lds, wid, lane, wk, nw, PREP_I_GU, 2 * PREP_I_GU);
    if (l == 0 && w == 2) prep_layer(p, 0, lds, wid, lane, wk, nw, 2 * PREP_I_GU + PREP_I_DN, 2 * PREP_I_GU + 2 * PREP_I_DN);
    __syncthreads();
    if (l == 0 && w == 0) fold_items(p, lds, tid, 0, 64, worker_wg, n_wg);
    if (w == 2 && l + 1 < DEPTH) fold_items(p, lds, tid, 64 * (l + 1), 64 * (l + 2), worker_wg, n_wg);
}

__device__ __forceinline__ void fold_items(const Params& p, LAS unsigned char* lds, int tid, int it0, int it1, int worker_wg, int n_wg) {
    LAS float* wp = (LAS float*)lds;
    LAS float* wcs = (LAS float*)(lds + 65536);
    for (int it = it0 + worker_wg; it < it1; it += n_wg) {
        const int l = it >> 6, g = (it >> 4) & 3, n0 = (it & 15) * 64;
        const float* wpg = p.wpool + (size_t)(l * 4 + g) * 128 * 128;
        for (int i = tid; i < 128 * 128 / 4; i += NTHREADS) *(LAS f32x4*)(wp + i * 4) = *(const f32x4*)(wpg + i * 4);
        for (int i = tid; i < 128 * 64 / 4; i += NTHREADS) { const int d = i >> 4, n4 = (i & 15) * 4;
            const float sc = p.pscale[l * 512 + g * 128 + d];
            f32x4 v = *(const f32x4*)(p.wc + ((size_t)l * 512 + g * 128 + d) * D + n0 + n4);
            *(LAS f32x4*)(wcs + d * 64 + n4) = v * sc; }
        __syncthreads();
        const int n = tid & 63, cgp = tid >> 6;
        float a[16];
#pragma unroll
        for (int i = 0; i < 16; ++i) a[i] = 0.f;
        for (int d = 0; d < 128; ++d) { const float wv = wcs[d * 64 + n];
#pragma unroll
            for (int i = 0; i < 16; ++i) a[i] += wp[(16 * cgp + i) * 128 + d] * wv; }
        bf16_t* o = (bf16_t*)(p.ws + WS_WC) + (size_t)l * 1024 * 512 + (size_t)(n0 + n) * 512 + g * 128 + 16 * cgp;
        u32x4 w0, w1;
        w0.x = cvt_pk_bf16(a[0], a[1]); w0.y = cvt_pk_bf16(a[2], a[3]); w0.z = cvt_pk_bf16(a[4], a[5]); w0.w = cvt_pk_bf16(a[6], a[7]);
        w1.x = cvt_pk_bf16(a[8], a[9]); w1.y = cvt_pk_bf16(a[10], a[11]); w1.z = cvt_pk_bf16(a[12], a[13]); w1.w = cvt_pk_bf16(a[14], a[15]);
        *(u32x4*)o = w0; *(u32x4*)(o + 8) = w1;
        __syncthreads();
    }
}
__device__ __forceinline__ void prep_phase(const Params& p, LAS unsigned char* lds, int tid, int wid, int lane) {
    { const int w = blockIdx.x * NWAVES + wid, nw = gridDim.x * NWAVES;
      prep_layer(p, 0, lds, wid, lane, w, nw, 0, PREP_I_GU); prep_layer(p, 0, lds, wid, lane, w, nw, 2 * PREP_I_GU, 2 * PREP_I_GU + PREP_I_DN); prep_layer(p, 0, lds, wid, lane, w, nw, 2 * PREP_I_GU + 2 * PREP_I_DN, PREP_PER_L); }
    __syncthreads();
}

template <int NR>
__device__ __forceinline__ void norm_rows(const Params& p, int mode, float cpost, const float* gpost, int nsplit, int row0, int rstride, int nvalid, int lane, bool dry) {
    bf16_t* XB = (bf16_t*)(p.ws + WS_H); const bf16_t* Mb = (const bf16_t*)(p.ws + WS_M); float* RS = (float*)(p.ws + WS_RS);
    float v[NR][2][8], mm[NR][2][8];
#pragma unroll
    for (int k = 0; k < NR; ++k) { const int row = row0 + (k < nvalid ? k : 0) * rstride;
        if (mode == 0) { const float* src = (row < TP ? p.xp + (size_t)row * D : p.xs + (size_t)(row - TP) * D);
#pragma unroll
            for (int j = 0; j < 2; ++j) load8f(src + lane * 8 + 512 * j, v[k][j]); }
        else {
#pragma unroll
            for (int j = 0; j < 2; ++j) load8bf(XB + (size_t)row * D + lane * 8 + 512 * j, v[k][j]);
#pragma unroll
            for (int j = 0; j < 2; ++j) {
                if (row < TP) load8bf(Mb + (size_t)row * D + lane * 8 + 512 * j, mm[k][j]);
                else { const float* pp = (const float*)(p.ws + WS_P) + (size_t)(row - TP) * D + lane * 8 + 512 * j; load8f(pp, mm[k][j]);
                    if constexpr (NR == 1) {
#pragma unroll
                        for (int sp = 1; sp < 11; ++sp) { const int spc = sp < nsplit ? sp : 0; const float msk = sp < nsplit ? 1.0f : 0.0f; float t8[8]; load8f(pp + (size_t)spc * TS * D, t8);
#pragma unroll
                            for (int e = 0; e < 8; ++e) mm[k][j][e] += msk * t8[e]; }
                    } else {
                        for (int sp = 1; sp < nsplit; ++sp) { float t8[8]; load8f(pp + (size_t)sp * TS * D, t8);
#pragma unroll
                            for (int e = 0; e < 8; ++e) mm[k][j][e] += t8[e]; } } } }
        } }
    float g8[2][8];
    if (mode != 0) { load8f(gpost + lane * 8, g8[0]); load8f(gpost + lane * 8 + 512, g8[1]); }
#pragma unroll
    for (int k = 0; k < NR; ++k) { const int row = row0 + (k < nvalid ? k : 0) * rstride;
        if (mode != 0) { float ss = 0.f;
#pragma unroll
            for (int j = 0; j < 2; ++j)
#pragma unroll
                for (int e = 0; e < 8; ++e) ss += mm[k][j][e] * mm[k][j][e];
            const float rs = cpost * rsqrtf(wave_sum(ss) * (1.0f / D) + EPS);
#pragma unroll
            for (int j = 0; j < 2; ++j)
#pragma unroll
                for (int e = 0; e < 8; ++e) v[k][j][e] += mm[k][j][e] * rs * g8[j][e]; }
        if (k < nvalid) {
            if (mode == 2) {
#pragma unroll
                for (int j = 0; j < 2; ++j) store8f(p.out + (size_t)row * D + lane * 8 + 512 * j, v[k][j]);
            } else {
                float ss = 0.f;
#pragma unroll
                for (int j = 0; j < 2; ++j) {
                    *(u32x4*)((dry ? (bf16_t*)(p.ws + WS_MG) : XB) + (size_t)row * D + lane * 8 + 512 * j) = pack8(v[k][j]);
#pragma unroll
                    for (int e = 0; e < 8; ++e) ss += v[k][j][e] * v[k][j][e]; }
                const float rs = rsqrtf(wave_sum(ss) * (1.0f / D) + EPS);
                if (lane == 0) (dry ? (float*)(p.ws + WS_AIN) : RS)[row] = rs;
            } } }
}
__device__ __forceinline__ void norm_phase(const Params& p, int mode, float cpost, const float* gpost, int nsplit, int wid, int lane, bool dry = false, bool sample_only = false) {
    const int gw = blockIdx.x * NWAVES + wid, NGW = gridDim.x * NWAVES;
    if (!sample_only) for (int row = gw; row < TP; row += 4 * NGW) { const int left = (TP - row + NGW - 1) / NGW; norm_rows<4>(p, mode, cpost, gpost, nsplit, row, NGW, left < 4 ? left : 4, lane, dry); }
    for (int row = TP + gw; row < T; row += NGW) norm_rows<1>(p, mode, cpost, gpost, nsplit, row, NGW, 1, lane, dry);
}

template <int NR>
__device__ __forceinline__ void norm0_rows(const Params& p, int row0, int rstride, int nvalid, int lane) {
    bf16_t* XB = (bf16_t*)(p.ws + WS_H); float* RS = (float*)(p.ws + WS_RS);
    f32x4 v[NR][4];
#pragma unroll
    for (int k = 0; k < NR; ++k) { const int row = row0 + (k < nvalid ? k : 0) * rstride;
        const float* src = (row < TP ? p.xp + (size_t)row * D : p.xs + (size_t)(row - TP) * D) + lane * 8;
        v[k][0] = *(const f32x4*)src; v[k][1] = *(const f32x4*)(src + 4); v[k][2] = *(const f32x4*)(src + 512); v[k][3] = *(const f32x4*)(src + 516); }
#pragma unroll
    for (int k = 0; k < NR; ++k) { const int row = row0 + (k < nvalid ? k : 0) * rstride;
        float ss = 0.f;
#pragma unroll
        for (int q = 0; q < 4; ++q) ss += (v[k][q][0] * v[k][q][0] + v[k][q][1] * v[k][q][1]) + (v[k][q][2] * v[k][q][2] + v[k][q][3] * v[k][q][3]);
        const float rs = rsqrtf(wave_sum(ss) * (1.0f / D) + EPS);
        if (k < nvalid) {
#pragma unroll
            for (int j = 0; j < 2; ++j) { u32x4 w; w.x = cvt_pk_bf16(v[k][2 * j][0], v[k][2 * j][1]); w.y = cvt_pk_bf16(v[k][2 * j][2], v[k][2 * j][3]);
                w.z = cvt_pk_bf16(v[k][2 * j + 1][0], v[k][2 * j + 1][1]); w.w = cvt_pk_bf16(v[k][2 * j + 1][2], v[k][2 * j + 1][3]);
                *(u32x4*)(XB + (size_t)row * D + lane * 8 + 512 * j) = w; }
            if (lane == 0) RS[row] = rs; } }
}
__device__ __forceinline__ void norm0_phase(const Params& p, int wid, int lane) {
    const int gw = blockIdx.x * NWAVES + wid, NGW = gridDim.x * NWAVES;
    for (int row = gw; row < TP; row += 8 * NGW) { const int left = (TP - row + NGW - 1) / NGW; norm0_rows<8>(p, row, NGW, left < 8 ? left : 8, lane); }
    for (int row = TP + gw; row < T; row += NGW) norm0_rows<1>(p, row, NGW, 1, lane);
}

__device__ __forceinline__ void sample_norm_head(const Params& p, float cpost, const float* gpost, int nsplit, unsigned* cnt, int c, int G) {
    if (c >= G - 64) {
        int tid = threadIdx.x; asm volatile("" : "+v"(tid));
        const int wid = __builtin_amdgcn_readfirstlane(tid >> 6), lane = tid & 63;
        norm_rows<1>(p, 1, cpost, gpost, nsplit, TP + (c - (G - 64)) * NWAVES + wid, 0, 1, lane, false);
        asm volatile("s_waitcnt vmcnt(0)" ::: "memory"); __syncthreads();
        if (threadIdx.x == 0) { __builtin_amdgcn_fence(__ATOMIC_RELEASE, "agent"); asm volatile("s_waitcnt vmcnt(0)" ::: "memory");
            __hip_atomic_fetch_add(cnt, 1u, __ATOMIC_RELAXED, __HIP_MEMORY_SCOPE_AGENT); }
    }
}

template <int W>
__device__ __forceinline__ void bc_group(const Params& p, int l, bool smp, size_t rg, int ch, const bf16_t* MIX, bf16_t* BIN, bf16_t* CIN) {
    constexpr int NP = W - 1 + 4;
    int t0, b; if (!smp) { t0 = (int)(rg & 2047); b = (int)(rg >> 11); } else { t0 = 0; b = ((int)rg - TP) >> 2; }
    const bf16_t* mr = MIX + rg * DIN;
    u32x4 praw[NP];
    float Z[6][8];
    u32x4 graw[4];
    {
        u32x4 xraw[6], craw[6];
#pragma unroll
        for (int j = -(W - 1); j <= 3; ++j) { const int jj = (j >= 0 || t0 + j >= 0) ? j : 0; praw[j + W - 1] = *(const u32x4*)(mr + (ptrdiff_t)jj * DIN + 2560 + ch); }
#pragma unroll
        for (int j = -2; j <= 3; ++j) { const int jj = (j >= 0 || t0 + j >= 0) ? j : 0; xraw[j + 2] = *(const u32x4*)(mr + (ptrdiff_t)jj * DIN + 1024 + ch); craw[j + 2] = *(const u32x4*)(mr + (ptrdiff_t)jj * DIN + 2048 + ch); }
#pragma unroll
        for (int i = 0; i < 4; ++i) graw[i] = *(const u32x4*)(mr + (size_t)i * DIN + 1536 + ch);
#pragma unroll
        for (int j = -(W - 1); j < 0; ++j) { if (t0 + j < 0) praw[j + W - 1] = (u32x4){0u, 0u, 0u, 0u}; }
#pragma unroll
        for (int j = -2; j <= 3; ++j) { const float msk = (j >= 0 || t0 + j >= 0) ? 1.0f : 0.0f; float xv[8], cv[8]; unpack8(xraw[j + 2], xv); unpack8(craw[j + 2], cv);
#pragma unroll
            for (int e = 0; e < 8; ++e) Z[j + 2][e] = (j < 0 ? msk : 1.0f) * xv[e] * cv[e]; }
    }
    if (smp) {
        const float* sp = p.spool + ((size_t)(l * 128 + b) * 15) * 512 + ch;
#pragma unroll
        for (int j = -(W - 1); j < 0; ++j) { float t8[8]; load8f(sp + (size_t)(15 + j) * 512, t8); praw[j + W - 1] = pack8(t8); }
        const float* sc = p.sconv + ((size_t)(l * 128 + b) * 2) * 512 + ch;
        load8f(sc, Z[0]); load8f(sc + 512, Z[1]);
    }
    {
        float w0[8], w1[8], w2[8]; load8f(p.wconv + (l * 3 + 0) * 512 + ch, w0); load8f(p.wconv + (l * 3 + 1) * 512 + ch, w1); load8f(p.wconv + (l * 3 + 2) * 512 + ch, w2);
#pragma unroll
        for (int i = 0; i < 4; ++i) { float o[8], gv[8]; unpack8(graw[i], gv);
#pragma unroll
            for (int e = 0; e < 8; ++e) o[e] = gv[e] * (w0[e] * Z[i][e] + w1[e] * Z[i + 1][e] + w2[e] * Z[i + 2][e]);
            *(u32x4*)(BIN + (rg + i) * 512 + ch) = pack8(o); }
    }
    if (!smp) { if (t0 == PAST_T - 4) { store8f(p.out + O_CONV_P + ((size_t)(l * 8 + b) * 2 + 0) * 512 + ch, Z[4]); store8f(p.out + O_CONV_P + ((size_t)(l * 8 + b) * 2 + 1) * 512 + ch, Z[5]); } }
    else { store8f(p.out + O_CONV_S + ((size_t)(l * 128 + b) * 2 + 0) * 512 + ch, Z[4]); store8f(p.out + O_CONV_S + ((size_t)(l * 128 + b) * 2 + 1) * 512 + ch, Z[5]); }
    float sm[8];
#pragma unroll
    for (int e = 0; e < 8; ++e) sm[e] = 0.f;
#pragma unroll
    for (int j = -(W - 1); j <= 0; ++j) { float pv[8]; unpack8(praw[j + W - 1], pv);
#pragma unroll
        for (int e = 0; e < 8; ++e) sm[e] += pv[e]; }
#pragma unroll
    for (int i = 0; i < 4; ++i) {
        float pi[8]; unpack8(praw[i + W - 1], pi);
        if (i > 0) { float po[8]; unpack8(praw[i - 1], po);
#pragma unroll
            for (int e = 0; e < 8; ++e) sm[e] += pi[e] - po[e]; }
        const float inv = 1.0f / (float)(smp ? W : (t0 + i + 1 < W ? t0 + i + 1 : W));
        float o[8];
#pragma unroll
        for (int e = 0; e < 8; ++e) o[e] = sm[e] * inv - pi[e];
        *(u32x4*)(CIN + (rg + i) * 512 + ch) = pack8(o);
        if (!smp) { const int t = t0 + i; if (t >= PAST_T - 15) store8f(p.out + O_POOL_P + ((size_t)(l * 8 + b) * 15 + (t - (PAST_T - 15))) * 512 + ch, pi); }
        else store8f(p.out + O_POOL_S + ((size_t)(l * 128 + b) * 15 + 11 + i) * 512 + ch, pi);
    }
    if (smp) {
        const float* sp = p.spool + ((size_t)(l * 128 + b) * 15) * 512 + ch;
#pragma unroll
        for (int jr = 0; jr < 11; ++jr) { float cp[8]; load8f(sp + (size_t)(jr + 4) * 512, cp); store8f(p.out + O_POOL_S + ((size_t)(l * 128 + b) * 15 + jr) * 512 + ch, cp); }
    }
}

__device__ __forceinline__ void mid_phase(const Params& p, int l, LAS unsigned char* lds, int tid, int wid, int lane, int item0, int item_end, int item_step) {
    constexpr int PITCH = 136;
    LAS bf16_t* WsL = (LAS bf16_t*)lds;
    LAS bf16_t* VsT = (LAS bf16_t*)(lds + 128 * PITCH * 2);
    LAS float* St = (LAS float*)(lds + RING_BYTES);
    const bf16_t* MIX = (const bf16_t*)(p.ws + WS_MIX);
    bf16_t* AIN = (bf16_t*)(p.ws + WS_AIN); bf16_t* BIN = (bf16_t*)(p.ws + WS_BIN); bf16_t* CIN = (bf16_t*)(p.ws + WS_CIN);
    for (int item = item0; item < item_end; item += item_step) {
        const int rb = item >> 2, q = item & 3, r0 = rb * 128; const bool smp = rb >= TP / 128;
        asm volatile("" : "+v"(tid), "+v"(lane));
        u32x4 vraw[2][2]; unsigned long long uraw[8];
        {
            u32x4 raw[16];
#pragma unroll
            for (int rr = 0; rr < 16; ++rr) raw[rr] = *(const u32x4*)(MIX + (size_t)(r0 + wid * 16 + rr) * DIN + 512 + lane * 8);
#pragma unroll
            for (int k = 0; k < 2; ++k) { const int s0 = 2 * ((tid >> 4) + 32 * k); const bf16_t* vp = MIX + (size_t)(r0 + s0) * DIN + 512 + q * 128 + (tid & 15) * 8;
                vraw[k][0] = *(const u32x4*)vp; vraw[k][1] = *(const u32x4*)(vp + DIN); }
#pragma unroll
            for (int n = 0; n < 8; ++n) uraw[n] = *(const unsigned long long*)(MIX + (size_t)(r0 + 16 * wid + (lane & 15)) * DIN + q * 128 + 16 * n + 4 * (lane >> 4));
#pragma unroll
            for (int rr = 0; rr < 16; ++rr) { const int row = wid * 16 + rr;
                float f[8]; unpack8(raw[rr], f);
                float s = ((f[0] + f[1]) + (f[2] + f[3])) + ((f[4] + f[5]) + (f[6] + f[7]));
                const float mean = wave_sum(s) * (1.0f / 512.0f); float qv = 0.f;
#pragma unroll
                for (int j = 0; j < 8; ++j) { const float d = f[j] - mean; qv += d * d; }
                const float rstd = rsqrtf(wave_sum(qv) * (1.0f / 512.0f) + EPS);
                if (lane == 0) { St[2 * row] = mean; St[2 * row + 1] = rstd; } }
        }
        {
            const float* wsg = p.wsp + (size_t)(l * 4 + q) * 128 * 128;
#pragma unroll
            for (int k = 0; k < 4; ++k) { const int idx = tid + 512 * k, t = idx >> 4, s8 = (idx & 15) * 8;
                float w8[8];
                if (!smp) { load8f(wsg + t * 128 + s8, w8);
#pragma unroll
                    for (int e = 0; e < 8; ++e) w8[e] = (s8 + e <= t) ? w8[e] : 0.f; }
                else {
#pragma unroll
                    for (int e = 0; e < 8; ++e) { const int j = s8 + e; const bool on = ((j >> 2) == (t >> 2)) && ((j & 3) <= (t & 3)); w8[e] = on ? wsg[(t & 3) * 128 + (j & 3)] : 0.f; } }
                *(LAS u32x4*)(WsL + t * PITCH + s8) = pack8(w8); }
        }
        __syncthreads();
        const int cg8 = tid & 15, rq = tid >> 4, ch = q * 128 + cg8 * 8;
        {
            float g8[8], b8[8]; load8f(p.lng + l * 512 + ch, g8); load8f(p.lnb + l * 512 + ch, b8);
#pragma unroll
            for (int k = 0; k < 2; ++k) { const int s0 = 2 * (rq + 32 * k);
                float fa[8], fb[8]; unpack8(vraw[k][0], fa); unpack8(vraw[k][1], fb);
                const float ma = St[2 * s0], ra = St[2 * s0 + 1], mb = St[2 * s0 + 2], rb2 = St[2 * s0 + 3];
#pragma unroll
                for (int j = 0; j < 8; ++j) { fa[j] = (fa[j] - ma) * ra * g8[j] + b8[j]; fb[j] = (fb[j] - mb) * rb2 * g8[j] + b8[j]; }
                if (smp) { store8f(p.out + O_V_S + ((size_t)l * 512 + (r0 - TP + s0)) * 512 + ch, fa); store8f(p.out + O_V_S + ((size_t)l * 512 + (r0 - TP + s0 + 1)) * 512 + ch, fb);
}
#pragma unroll
                for (int j = 0; j < 8; ++j) *(LAS unsigned*)(VsT + (cg8 * 8 + j) * PITCH + s0) = cvt_pk_bf16(fa[j], fb[j]); }
        }
        __syncthreads();
        {
            const int fr = lane & 15, fq = lane >> 4;
            f32x4 acc[8];
#pragma unroll
            for (int n = 0; n < 8; ++n) acc[n] = (f32x4){0.f, 0.f, 0.f, 0.f};
            const int nkb = (wid >> 1) + 1;
            for (int kb = 0; kb < nkb; ++kb) {
                const bf16x8 af = *(const LAS bf16x8*)(WsL + (16 * wid + fr) * PITCH + kb * 32 + 8 * fq);
#pragma unroll
                for (int n = 0; n < 8; ++n) { const bf16x8 bfr = *(const LAS bf16x8*)(VsT + (16 * n + fr) * PITCH + kb * 32 + 8 * fq);
                    acc[n] = __builtin_amdgcn_mfma_f32_16x16x32_bf16(bfr, af, acc[n], 0, 0, 0); }
            }
            const int t = 16 * wid + fr; const size_t row = (size_t)(r0 + t);
            const float bias = p.bs[(l * 4 + q) * 128 + (smp ? (t & 3) : t)];
#pragma unroll
            for (int n = 0; n < 8; ++n) { const int c0 = q * 128 + 16 * n + 4 * fq;
                const unsigned long long uw = uraw[n];
                const unsigned lo = (unsigned)uw, hi = (unsigned)(uw >> 32);
                const float o0 = bf_lo(lo) * (acc[n][0] + bias), o1 = bf_hi(lo) * (acc[n][1] + bias), o2 = bf_lo(hi) * (acc[n][2] + bias), o3 = bf_hi(hi) * (acc[n][3] + bias);
                *(unsigned long long*)(AIN + row * 512 + c0) = (unsigned long long)cvt_pk_bf16(o0, o1) | ((unsigned long long)cvt_pk_bf16(o2, o3) << 32); }
        }
        {
            const size_t rg = (size_t)(r0 + 4 * rq);
            if (q == 0) bc_group<2>(p, l, smp, rg, ch, MIX, BIN, CIN); else if (q == 1) bc_group<4>(p, l, smp, rg, ch, MIX, BIN, CIN);
            else if (q == 2) bc_group<8>(p, l, smp, rg, ch, MIX, BIN, CIN); else bc_group<16>(p, l, smp, rg, ch, MIX, BIN, CIN);
        }
        __syncthreads();
    }
}

#define XB_TMO      128
#define XB_XCNT(j)  (256  + 64 * (j))
#define XB_XSUB(j)  (1280 + 64 * (j))
#define XB_XGEN(j)  (2304 + 64 * (j))
#define XB_TOP      3328
#define XB_TOPGEN   3392
#define XCD_BAR_WORDS 3456
#define XB_SPIN_CAP (1u << 18)
__device__ __forceinline__ unsigned xb_ld(unsigned* p)              { return __hip_atomic_load(p, __ATOMIC_RELAXED, __HIP_MEMORY_SCOPE_AGENT); }
__device__ __forceinline__ unsigned xb_add(unsigned* p, unsigned v) { return __hip_atomic_fetch_add(p, v, __ATOMIC_RELAXED, __HIP_MEMORY_SCOPE_AGENT); }
__device__ __forceinline__ unsigned xb_xcc_id() { return (unsigned)__builtin_amdgcn_s_getreg((3 << 11) | 20) & 0xFu; }
#define XB_SPIN(cond, bar) do { unsigned _sp = 0; while (cond) { __builtin_amdgcn_s_sleep(1); \
    if ((++_sp & 255u) == 0u) { if (xb_ld(&(bar)[XB_TMO])) break; if (_sp > XB_SPIN_CAP) { atomicAdd(&(bar)[XB_TMO], 1u); break; } } } } while (0)
struct XcdBarrier { unsigned* bar; unsigned x; volatile LAS unsigned* st; };
__device__ __forceinline__ XcdBarrier xcd_barrier_post(unsigned* bar, volatile LAS unsigned* st) {
    XcdBarrier b; b.bar = bar; b.x = xb_xcc_id(); b.st = st;
    if (threadIdx.x == 0) (void)xb_add(&bar[XB_XCNT(b.x)], 1u);
    return b;
}
__device__ __forceinline__ void xcd_barrier_complete(unsigned* bar, unsigned x, unsigned& nloc, unsigned& nx) {
    const unsigned G = gridDim.x * gridDim.y * gridDim.z;
    unsigned sum, cnt, mine, sp = 0u;
    for (;;) {
        sum = 0u; cnt = 0u; mine = 0u;
#pragma unroll
        for (unsigned j = 0; j < 16; ++j) { const unsigned c = xb_ld(&bar[XB_XCNT(j)]); sum += c; cnt += (c > 0u) ? 1u : 0u; mine = (j == x) ? c : mine; }
        if (sum == G) break;
        __builtin_amdgcn_s_sleep(1);
        if ((++sp & 255u) == 0u) { if (xb_ld(&bar[XB_TMO])) break; if (sp > XB_SPIN_CAP) { atomicAdd(&bar[XB_TMO], 1u); break; } }
    }
    nloc = mine > 0u ? mine : 1u; nx = cnt > 0u ? cnt : 1u;
}
__device__ __forceinline__ void xcd_barrier(const XcdBarrier& b) {
    asm volatile("s_waitcnt vmcnt(0)" ::: "memory");
    __syncthreads();
    if (threadIdx.x == 0) {
        unsigned* bar = b.bar;
        __builtin_amdgcn_s_waitcnt(0);
        asm volatile("buffer_inv sc1" ::: "memory");
        unsigned nloc = b.st[0], nx = b.st[1];
        if (nloc == 0u) { xcd_barrier_complete(bar, b.x, nloc, nx); b.st[0] = nloc; b.st[1] = nx; }
        const unsigned old = xb_add(&bar[XB_XSUB(b.x)], 1u);
        const unsigned gen = old / nloc;
        if (old + 1u == (gen + 1u) * nloc) {
            __builtin_amdgcn_fence(__ATOMIC_RELEASE, "agent");
            asm volatile("s_waitcnt vmcnt(0)" ::: "memory");
            const unsigned og = xb_add(&bar[XB_TOP], 1u);
            const unsigned tg = og / nx;
            if (og + 1u == (tg + 1u) * nx) xb_add(&bar[XB_TOPGEN], 1u);
            else XB_SPIN(xb_ld(&bar[XB_TOPGEN]) == tg, bar);
            asm volatile("" ::: "memory");
            xb_add(&bar[XB_XGEN(b.x)], 1u);
            asm volatile("s_waitcnt vmcnt(0)" ::: "memory");
        } else {
            XB_SPIN(xb_ld(&bar[XB_XGEN(b.x)]) == gen, bar);
            asm volatile("s_waitcnt vmcnt(0)" ::: "memory");
        }
    }
    __syncthreads();
}

__global__ void __launch_bounds__(NTHREADS, 2) mk_fwd(Params p) {
    extern __shared__ __attribute__((aligned(16))) unsigned char lds_raw[];
    LAS unsigned char* lds = (LAS unsigned char*)lds_raw;
    const int G = gridDim.x, c = blockIdx.x;
#define TIDS() int tid = threadIdx.x; asm volatile("" : "+v"(tid)); const int wid = __builtin_amdgcn_readfirstlane(tid >> 6), lane = tid & 63; (void)wid; (void)lane
    int ph = 0;
#if MK_COOP
    cg::grid_group grid = cg::this_grid();
    volatile LAS unsigned* bst = (volatile LAS unsigned*)(lds + RING_BYTES + 2048);
    if (threadIdx.x < 2) bst[threadIdx.x] = 0u;
    __syncthreads();
    const XcdBarrier xbar = xcd_barrier_post((unsigned*)(p.ws + WS_CTL), bst);
    if (p.ph_hi > 100000) grid.sync();
#define SEAM() do { if (ph + 1 < p.ph_hi) xcd_barrier(xbar); } while (0)
#else
#define SEAM() do { } while (0)
#endif
#ifndef PR_PREP
#define PR_PREP 1
#endif
#ifndef PR_MID
#define PR_MID 1
#endif
#ifndef PR_GEMM
#define PR_GEMM 1
#endif
#ifndef PR_SYNC
#define PR_SYNC 1
#endif
#define RUNR(rep, ...) do { if (ph >= p.ph_lo && ph < p.ph_hi) { _Pragma("unroll 1") for (int rep_ = 0; rep_ < (rep); ++rep_) { __VA_ARGS__; } _Pragma("unroll 1") for (int rep_ = 0; rep_ < PR_SYNC; ++rep_) SEAM(); } ++ph; } while (0)
#ifndef PR_NORM
#define PR_NORM 0
#endif
#ifndef PR_GU
#define PR_GU 1
#endif
#ifndef PR_DN
#define PR_DN 1
#endif
#ifndef PR_IN
#define PR_IN 1
#endif
#ifndef PR_BR
#define PR_BR 1
#endif
#ifndef PR_WO
#define PR_WO 1
#endif
#define RUN(...) RUNR(1, __VA_ARGS__)
#define RUNG(...) RUNR(PR_GEMM, __VA_ARGS__)
    const bf16_t* Hb = (const bf16_t*)(p.ws + WS_H);
    bf16_t* ACT = (bf16_t*)(p.ws + WS_MIX);
    bf16_t* MIX = (bf16_t*)(p.ws + WS_MIX);
    bf16_t* Mb = (bf16_t*)(p.ws + WS_M);
    const float* RSb = (const float*)(p.ws + WS_RS);
    float* Pb = (float*)(p.ws + WS_P);
    bf16_t* MG = (bf16_t*)(p.ws + WS_MG);

    RUNR(PR_PREP, { TIDS(); norm0_phase(p, wid, lane); prep_phase(p, lds, tid, wid, lane); });
#pragma unroll 1
    for (int l = 0; l < DEPTH; ++l) {
        const float* g = p.ng + (size_t)l * 6 * D;
#pragma unroll 1
        for (int j = 0; j < 2; ++j) {
            RUNR(PR_GEMM * PR_GU, {
                  const bool has_sn = !(l == 0 && j == 0);
                  unsigned* sn = (unsigned*)(p.ws + WS_CTL + CTL_SN) + 64 * (j == 0 ? (l * 3 - 1) : (l * 3 + 1));
                  if (has_sn && rep_ == 0) { if (j == 0) sample_norm_head(p, 0.5f, g - D, 11, sn, c, G); else sample_norm_head(p, 1.0f, g + 3 * D, 8, sn, c, G); }
                  Sched S; S.nM = T / BM; S.nN = 2 * FF / BM; S.nwg = S.nM * S.nN; S.G = G; S.c = c; S.ready = nullptr; S.need = 0; S.xfirst = 0; S.nsub = 1; S.nt = D / BK; S.xS = 0; S.xnt = 0; S.xKS = 1; S.xA0 = nullptr; S.xAp = 0; S.tstep = (size_t)BM * D * 2;
                  S.dA = S.dB = 0; S.A0 = (const char*)Hb; S.B0 = (const char*)(p.ws + WS_WGU + (size_t)(l * 2 + j) * SZ_WGU);
                  if (has_sn) { S.ready = sn; S.need = 64u; }
                  EpiSwiGLU E{ACT, RSb}; gemm_phase<EpiSwiGLU>(lds, D, S, E);
                  { const int rem = S.nwg % G; if (rep_ == 0 && rem != 0 && c >= rem) prep_window(p, l, j == 0 ? 0 : 3, lds, c - rem, G - rem); } });
            RUNR(PR_GEMM * PR_DN, { Sched S; S.nM = TP / BM; S.nN = D / BM; S.nwg = S.nM * S.nN; S.G = G; S.c = c; S.ready = nullptr; S.need = 0; S.xfirst = 1; S.nsub = 1; S.nt = FF / BK; S.xS = 11; S.xnt = 4; S.xKS = 11; S.xA0 = (const char*)ACT + (size_t)64 * BM * FF * 2; S.xAp = 0; S.tstep = (size_t)BM * FF * 2;
                  S.dA = S.dB = 0; S.A0 = (const char*)ACT; S.B0 = (const char*)(p.ws + WS_WDN + (size_t)(l * 2 + j) * SZ_WDN);
                  unsigned* pc = (unsigned*)(p.ws + WS_CTL + 16384) + (size_t)((l * 3 + (j == 0 ? 0 : 2)) * 2) * 64 * 16;
                  EpiM E{Pb, (bf16_t*)(p.ws + WS_H), (float*)(p.ws + WS_RS), p.out, g + (j == 0 ? 1 : 5) * D, 0.5f, (float*)(p.ws + WS_X1), (float*)(p.ws + WS_X2), pc, pc + 64 * 16, (j == 1 && l == DEPTH - 1) ? 1 : 0};
                  gemm_phase<EpiM>(lds, FF, S, E); });
            if (j == 0) {
                RUNR(PR_GEMM * PR_IN, {
                      unsigned* sn = (unsigned*)(p.ws + WS_CTL + CTL_SN) + 64 * (l * 3);
                      if (rep_ == 0) sample_norm_head(p, 0.5f, g + D, 11, sn, c, G);
                      Sched S; S.nM = T / BM; S.nN = DIN / BM; S.nwg = S.nM * S.nN; S.G = G; S.c = c; S.ready = nullptr; S.need = 0; S.xfirst = 0; S.nsub = 1; S.nt = D / BK; S.xS = 0; S.xnt = 0; S.xKS = 1; S.xA0 = nullptr; S.xAp = 0; S.tstep = (size_t)BM * D * 2;
                      S.dA = S.dB = 0; S.A0 = (const char*)Hb; S.B0 = (const char*)(p.ws + WS_WIN + (size_t)l * SZ_WIN);
                      S.ready = sn; S.need = 64u;
                      EpiMix E{MIX, RSb}; gemm_phase<EpiMix>(lds, D, S, E);
                      { const int rem = S.nwg % G; if (rep_ == 0 && rem != 0 && c >= rem) prep_window(p, l, 1, lds, c - rem, G - rem); } });
                RUNR(PR_MID, { TIDS(); mid_phase(p, l, lds, tid, wid, lane, c, (TP / 128) * 4, G); });
                RUNR(PR_GEMM * PR_BR, {
                      unsigned* cnt = (unsigned*)(p.ws + WS_CTL) + 3520 + 64 * l;
                      if (rep_ == 0 && c >= G - 16) { TIDS(); mid_phase(p, l, lds, tid, wid, lane, (TP / 128) * 4 + (c - (G - 16)), (TP / 128) * 4 + (c - (G - 16)) + 1, 1);
                          asm volatile("s_waitcnt vmcnt(0)" ::: "memory"); __syncthreads();
                          if (threadIdx.x == 0) { __builtin_amdgcn_fence(__ATOMIC_RELEASE, "agent"); asm volatile("s_waitcnt vmcnt(0)" ::: "memory");
                              __hip_atomic_fetch_add(cnt, 1u, __ATOMIC_RELAXED, __HIP_MEMORY_SCOPE_AGENT); } }
                      Sched S; S.nM = TP / BM; S.nN = D / BM; S.nwg = S.nM * S.nN; S.G = G; S.c = c; S.ready = cnt; S.need = 16u; S.xfirst = 0; S.nsub = 3; S.nt = 512 / BK; S.xS = 2; S.xnt = 4; S.xKS = 2; S.xA0 = (const char*)(p.ws + WS_AIN) + (size_t)64 * BM * 512 * 2; S.xAp = 0; S.tstep = (size_t)BM * 512 * 2;
                      S.A0 = (const char*)(p.ws + WS_AIN); S.dA = WS_BIN - WS_AIN; S.B0 = (const char*)(p.ws + WS_WA + (size_t)l * SZ_WBR); S.dB = WS_WB - WS_WA;
                      EpiBranch E{MIX + 3072, MG, (bf16_t*)(p.ws + WS_MGP)}; gemm_phase<EpiBranch>(lds, 512, S, E);
                      if (rep_ == 0 && c >= 16 && c < G - 16) prep_window(p, l, 2, lds, c - 16, G - 32);
                      });

                RUNR(PR_GEMM * PR_WO, { Sched S; S.nM = TP / BM; S.nN = D / BM; S.nwg = S.nM * S.nN; S.G = G; S.c = c; S.ready = nullptr; S.need = 0; S.xfirst = 1; S.nsub = 1; S.nt = D / BK; S.xS = 8; S.xnt = 4; S.xKS = 4; S.xA0 = (const char*)(p.ws + WS_MGP); S.xAp = (size_t)TS * D * 2; S.tstep = (size_t)BM * D * 2;
                      S.dA = S.dB = 0; S.A0 = (const char*)MG; S.B0 = (const char*)(p.ws + WS_WO + (size_t)l * SZ_WO);
                      unsigned* pc = (unsigned*)(p.ws + WS_CTL + 16384) + (size_t)((l * 3 + 1) * 2) * 64 * 16;
                      EpiM E{Pb, (bf16_t*)(p.ws + WS_H), (float*)(p.ws + WS_RS), p.out, g + 3 * D, 1.0f, (float*)(p.ws + WS_X1), (float*)(p.ws + WS_X2), pc, pc + 64 * 16, 0};
                      gemm_phase<EpiM>(lds, D, S, E); });
            }
        }
    }
    RUN({ TIDS(); norm_phase(p, 2, 0.5f, p.ng + (size_t)(3 * 6 + 5) * D, 11, wid, lane, false, true); });
#undef RUN
#undef RUNG
#undef RUNR
#undef SEAM
}
constexpr int N_PHASES = 1 + DEPTH * 8 + 1;

extern "C" void kernel_launch(void* const* d_in, const int* in_sizes, int n_in, void* d_out, int out_size, void* d_ws, size_t ws_size, hipStream_t stream) {
    static int grid = 0;
    if (grid == 0) {
        if (n_in != 19 || (size_t)out_size != O_END || ws_size < WS_END) { fprintf(stderr, "kernel_launch: unexpected shapes (n_in %d out %d ws %zu need %zu)\n", n_in, out_size, ws_size, (size_t)WS_END); grid = -1; return; }
        int dev = 0, cus = 0, per_cu = 0;
        (void)hipGetDevice(&dev); (void)hipDeviceGetAttribute(&cus, hipDeviceAttributeMultiprocessorCount, dev);
        if (hipFuncSetAttribute((const void*)mk_fwd, hipFuncAttributeMaxDynamicSharedMemorySize, LDS_BYTES) != hipSuccess) { fprintf(stderr, "kernel_launch: hipFuncSetAttribute failed\n"); grid = -1; return; }
        if (hipOccupancyMaxActiveBlocksPerMultiprocessor(&per_cu, (const void*)mk_fwd, NTHREADS, LDS_BYTES) != hipSuccess || per_cu < 1) { fprintf(stderr, "kernel_launch: occupancy query says %d\n", per_cu); per_cu = 1; }
        (void)hipGetLastError();
        grid = cus * 1;
        fprintf(stderr, "kernel_launch: cus %d per_cu %d grid %d\n", cus, per_cu, grid);
    }
    if (grid < 0) return;
    if (hipMemsetAsync((char*)d_ws + WS_CTL, 0, CTL_BYTES, stream) != hipSuccess) { fprintf(stderr, "kernel_launch: memset failed\n"); return; }
    Params p{};
    p.xp = (const float*)d_in[0]; p.xs = (const float*)d_in[1]; p.sconv = (const float*)d_in[2]; p.spool = (const float*)d_in[3]; p.ng = (const float*)d_in[4];
    p.wgu = (const float*)d_in[5]; p.wdn = (const float*)d_in[6]; p.win = (const float*)d_in[7]; p.wsp = (const float*)d_in[8]; p.bs = (const float*)d_in[9];
    p.lng = (const float*)d_in[10]; p.lnb = (const float*)d_in[11]; p.wconv = (const float*)d_in[12]; p.wpool = (const float*)d_in[13]; p.pscale = (const float*)d_in[14];
    p.wa = (const float*)d_in[15]; p.wb = (const float*)d_in[16]; p.wc = (const float*)d_in[17]; p.wo = (const float*)d_in[18];
    p.out = (float*)d_out; p.ws = (unsigned char*)d_ws;
#if MK_COOP
    p.ph_lo = 0; p.ph_hi = N_PHASES;
    void* args[] = {&p};
    hipError_t e = hipLaunchCooperativeKernel((const void*)mk_fwd, dim3(grid), dim3(NTHREADS), args, LDS_BYTES, stream);
    if (e != hipSuccess) fprintf(stderr, "cooperative launch failed: %s (grid %d)\n", hipGetErrorString(e), grid);
#else
    for (int k = 0; k < N_PHASES; ++k) { p.ph_lo = k; p.ph_hi = k + 1; hipLaunchKernelGGL(mk_fwd, dim3(grid), dim3(NTHREADS), LDS_BYTES, stream, p); }
#endif
}
```

```cpp
#include <hip/hip_runtime.h>
#include <hip/hip_cooperative_groups.h>
#include <cstdio>
#include <cstdint>
namespace cg = cooperative_groups;

#ifndef MK_COOP
#define MK_COOP 1
#endif

#define LAS __attribute__((address_space(3)))
typedef unsigned short bf16_t;
typedef short bf16x8 __attribute__((ext_vector_type(8)));
typedef float f32x4 __attribute__((ext_vector_type(4)));
typedef unsigned u32x4 __attribute__((ext_vector_type(4)));

constexpr int TP = 16384, TS = 512, T = TP + TS, D = 1024, FF = 2816, DIN = 6144, DEPTH = 4;
constexpr int PAST_T = 2048;
constexpr float EPS = 1e-6f;
constexpr int NTHREADS = 512, NWAVES = 8;
constexpr int RING_BYTES = 131072, LDS_BYTES = 147456;

constexpr size_t SZ_WGU = (size_t)5632 * 1024 * 2, SZ_WDN = (size_t)1024 * 2816 * 2, SZ_WIN = (size_t)6144 * 1024 * 2, SZ_WBR = (size_t)1024 * 512 * 2, SZ_WO = (size_t)1024 * 1024 * 2;
constexpr size_t WS_WGU = 0;
constexpr size_t WS_WDN = WS_WGU + 8 * SZ_WGU;
constexpr size_t WS_WIN = WS_WDN + 8 * SZ_WDN;
constexpr size_t WS_WA = WS_WIN + 4 * SZ_WIN;
constexpr size_t WS_WB = WS_WA + 4 * SZ_WBR;
constexpr size_t WS_WC = WS_WB + 4 * SZ_WBR;
constexpr size_t WS_WO = WS_WC + 4 * SZ_WBR;
constexpr size_t WS_H = WS_WO + 4 * SZ_WO;
constexpr size_t WS_M = WS_H + (size_t)T * D * 2;
constexpr size_t WS_MIX = WS_M + (size_t)T * D * 4;
constexpr size_t WS_AIN = WS_MIX + (size_t)T * DIN * 2;
constexpr size_t WS_BIN = WS_AIN + (size_t)T * 512 * 2;
constexpr size_t WS_CIN = WS_BIN + (size_t)T * 512 * 2;
constexpr size_t WS_MG = WS_CIN + (size_t)T * 512 * 2;
constexpr size_t WS_P = WS_MG + (size_t)T * D * 2;
constexpr size_t WS_MGP = WS_P + (size_t)11 * TS * D * 4;
constexpr size_t WS_RS = WS_MGP + (size_t)2 * TS * D * 2;
constexpr size_t WS_CTL = WS_RS + (size_t)T * 4 + 256;
constexpr size_t CTL_SN = 16384 + 12 * 64 * 2 * 64;
constexpr size_t CTL_BYTES = CTL_SN + 12 * 256;
constexpr size_t WS_X1 = WS_CTL + CTL_BYTES;
constexpr size_t WS_X2 = WS_X1 + (size_t)64 * 256 * 4 * 4;
constexpr size_t WS_END = WS_X2 + (size_t)64 * 256 * 4 * 4;
static_assert(WS_CIN - WS_BIN == WS_BIN - WS_AIN && WS_WC - WS_WB == WS_WB - WS_WA, "branch operand spacing");

constexpr size_t O_Y = 0;
constexpr size_t O_CONV_P = (size_t)T * D;
constexpr size_t O_POOL_P = O_CONV_P + (size_t)DEPTH * 8 * 2 * 512;
constexpr size_t O_CONV_S = O_POOL_P + (size_t)DEPTH * 8 * 15 * 512;
constexpr size_t O_POOL_S = O_CONV_S + (size_t)DEPTH * 128 * 2 * 512;
constexpr size_t O_V_S = O_POOL_S + (size_t)DEPTH * 128 * 15 * 512;
constexpr size_t O_END = O_V_S + (size_t)DEPTH * 128 * 4 * 512;

struct Params {
    const float *xp, *xs, *sconv, *spool, *ng, *wgu, *wdn, *win, *wsp, *bs, *lng, *lnb, *wconv, *wpool, *pscale, *wa, *wb, *wc, *wo;
    float* out; unsigned char* ws; int ph_lo, ph_hi;
};

__device__ __forceinline__ unsigned cvt_pk_bf16(float lo, float hi) { unsigned r; asm("v_cvt_pk_bf16_f32 %0, %1, %2" : "=v"(r) : "v"(lo), "v"(hi)); return r; }
__device__ __forceinline__ float bf_lo(unsigned w) { return __uint_as_float(w << 16); }
__device__ __forceinline__ float bf_hi(unsigned w) { return __uint_as_float(w & 0xffff0000u); }
__device__ __forceinline__ void unpack8(const u32x4 w, float (&f)[8]) { f[0] = bf_lo(w.x); f[1] = bf_hi(w.x); f[2] = bf_lo(w.y); f[3] = bf_hi(w.y); f[4] = bf_lo(w.z); f[5] = bf_hi(w.z); f[6] = bf_lo(w.w); f[7] = bf_hi(w.w); }
__device__ __forceinline__ u32x4 pack8(const float (&f)[8]) { u32x4 w; w.x = cvt_pk_bf16(f[0], f[1]); w.y = cvt_pk_bf16(f[2], f[3]); w.z = cvt_pk_bf16(f[4], f[5]); w.w = cvt_pk_bf16(f[6], f[7]); return w; }
__device__ __forceinline__ void load8f(const float* p, float (&f)[8]) { const f32x4 a = *(const f32x4*)p, b = *(const f32x4*)(p + 4); f[0] = a[0]; f[1] = a[1]; f[2] = a[2]; f[3] = a[3]; f[4] = b[0]; f[5] = b[1]; f[6] = b[2]; f[7] = b[3]; }
__device__ __forceinline__ void store8f(float* p, const float (&f)[8]) { *(f32x4*)p = (f32x4){f[0], f[1], f[2], f[3]}; *(f32x4*)(p + 4) = (f32x4){f[4], f[5], f[6], f[7]}; }
__device__ __forceinline__ void load8bf(const bf16_t* p, float (&f)[8]) { unpack8(*(const u32x4*)p, f); }
__device__ __forceinline__ float fsigmoid(float x) { return __builtin_amdgcn_rcpf(1.0f + __builtin_amdgcn_exp2f(-1.44269504089f * x)); }
__device__ __forceinline__ float fsilu(float x) { return x * fsigmoid(x); }
__device__ __forceinline__ float fgelu(float x) { const float u = x * (1.0f + 0.044715f * x * x); return x * fsigmoid(1.5957691216f * u); }
template <int CTRL> __device__ __forceinline__ float dpp_mov(float x) { return __builtin_bit_cast(float, __builtin_amdgcn_mov_dpp(__builtin_bit_cast(int, x), CTRL, 0xf, 0xf, true)); }
__device__ __forceinline__ float wave_sum(float x) {
    x += dpp_mov<0xB1>(x);
    x += dpp_mov<0x4E>(x);
    x += dpp_mov<0x141>(x);
    x += dpp_mov<0x128>(x);
    auto s = __builtin_amdgcn_permlane16_swap(__float_as_uint(x), __float_as_uint(x), false, false);
    x = __uint_as_float(s[0]) + __uint_as_float(s[1]);
    auto t = __builtin_amdgcn_permlane32_swap(__float_as_uint(x), __float_as_uint(x), false, false);
    return __uint_as_float(t[0]) + __uint_as_float(t[1]);
}

__device__ __forceinline__ void store16(void* ptr, u32x4 w, bool wt) {
    if (wt) asm volatile("global_store_dwordx4 %0, %1, off sc1\n\ts_nop 1" :: "v"(ptr), "v"(w) : "memory");
    else *(u32x4*)ptr = w;
}

constexpr int BM = 256, BK = 64, HALF = 128, HTB = HALF * BK * 2, NXCD = 8, WGM = 8;
__device__ __forceinline__ int lds_byte(int r, int c) { const int st = (r >> 4) * 2 + (c >> 5), rr = r & 15, cc = c & 31, ob = rr * 64 + cc * 2; return st * 1024 + (ob ^ (((ob >> 9) & 1) << 5)); }
__device__ __forceinline__ void stage_rc(int b, int& R, int& C) { const int st = b / 1024, sb = b % 1024, swz = sb ^ (((sb >> 9) & 1) << 5); R = (st >> 1) * 16 + swz / 64; C = (st & 1) * 32 + (swz % 64) / 2; }
__device__ __forceinline__ int perm32(int rho) { const int n = rho >> 4, i = rho & 15; return 8 * (i >> 2) + 4 * n + (i & 3); }

struct Unit { const char* A; const char* B; int pm, pn, sub, sp, nt; };

struct Sched {
    int nM, nN, nwg, G, c, nsub, nt; const char *A0, *B0; size_t dA, dB, tstep;
    int xS, xnt, xKS; const char* xA0; size_t xAp;
    const unsigned* ready; unsigned need;
    int xfirst;
    __device__ __forceinline__ bool next(int i, Unit& u) const {
        int tile = i / nsub; const int sub = i - tile * nsub;
        if (xfirst) { const bool hasx = c < 8 * xS; if (i > (hasx ? 1 : 0)) return false; tile = hasx ? 1 - i : 0; }
        const long L = (long)tile * G + c;
        if (L >= nwg) {
            const int e = (int)(L - nwg); if (e >= 8 * xS) return false;
            const int xt = e / xS, sp = e - xt * xS;
            u.pm = 64 + (xt >> 2); u.pn = xt & 3; u.sub = sub; u.sp = sp; u.nt = xnt;
            const int part = sp / xKS, ksp = sp - part * xKS;
            u.A = xA0 + (size_t)sub * dA + (size_t)part * xAp + (size_t)(xt >> 2) * tstep + (size_t)ksp * xnt * (BK * 2); u.B = B0 + (size_t)sub * dB + (size_t)u.pn * tstep + (size_t)ksp * xnt * (BK * 2);
            return true;
        }
        int wgid = (int)L; { const int q = nwg / NXCD, r = nwg % NXCD, xcd = wgid % NXCD, off = wgid / NXCD; wgid = (xcd < r ? xcd * (q + 1) : r * (q + 1) + (xcd - r) * q) + off; }
        const int nig = WGM * nN, gid = wgid / nig, fm = gid * WGM, gsz = (nM - fm) < WGM ? (nM - fm) : WGM;
        u.pm = fm + ((wgid % nig) % gsz); u.pn = (wgid % nig) / gsz; u.sub = sub; u.sp = 0; u.nt = nt;
        u.A = A0 + (size_t)sub * dA + (size_t)u.pm * tstep; u.B = B0 + (size_t)sub * dB + (size_t)u.pn * tstep;
        return true;
    }
    __device__ __forceinline__ void a_ready(const Unit& u) const {
        if (ready == nullptr || u.pm < 64 || u.sub != 0) return;
        if (threadIdx.x < 64) { unsigned sp_ = 0;
            while ((unsigned)__builtin_amdgcn_readfirstlane(__hip_atomic_load(ready, __ATOMIC_RELAXED, __HIP_MEMORY_SCOPE_AGENT)) < need) { __builtin_amdgcn_s_sleep(2); if (++sp_ > (1u << 22)) break; }
            __builtin_amdgcn_fence(__ATOMIC_ACQUIRE, "agent");
            asm volatile("s_waitcnt vmcnt(0)" ::: "memory"); }
        asm volatile("" ::: "memory"); __builtin_amdgcn_s_barrier(); asm volatile("" ::: "memory");
    }
};

#define ZERO_ACC() do { _Pragma("unroll") for (int a_ = 0; a_ < 2; ++a_) _Pragma("unroll") for (int b_ = 0; b_ < 2; ++b_) _Pragma("unroll") for (int m_ = 0; m_ < 4; ++m_) _Pragma("unroll") for (int n_ = 0; n_ < 2; ++n_) acc[a_][b_][m_][n_] = (f32x4){0.f, 0.f, 0.f, 0.f}; } while (0)

struct EpiSwiGLU {
    static constexpr bool PERM = true, FUSED = false;
    bf16_t* O; const float* RS;
    __device__ __forceinline__ void operator()(f32x4 (&acc)[2][2][4][2], const Unit& u, int wr, int wc, int fr, int fq) const {
        const int row0 = u.pm * BM + wr * 64 + fr, col0 = u.pn * 128 + wc * 32 + 8 * fq;
#pragma unroll
        for (int ai = 0; ai < 2; ++ai)
#pragma unroll
            for (int m = 0; m < 4; ++m) {
                const float rs = RS[row0 + ai * HALF + m * 16];
                u32x4 w;
                {
                    typedef float f32x2 __attribute__((ext_vector_type(2)));
                    unsigned wv[4];
#pragma unroll
                    for (int h = 0; h < 4; ++h) {
                        const f32x4 ga = acc[ai][0][m][h >> 1], ua = acc[ai][1][m][h >> 1];
                        const f32x2 g2 = (f32x2){ga[(h & 1) * 2], ga[(h & 1) * 2 + 1]} * rs, u2 = (f32x2){ua[(h & 1) * 2], ua[(h & 1) * 2 + 1]} * rs;
                        const f32x2 t2 = g2 * u2, a2 = g2 * (-1.44269504089f);
                        f32x2 e2; e2.x = __builtin_amdgcn_exp2f(a2.x); e2.y = __builtin_amdgcn_exp2f(a2.y);
                        const f32x2 d2 = e2 + 1.0f;
                        f32x2 r2; r2.x = __builtin_amdgcn_rcpf(d2.x); r2.y = __builtin_amdgcn_rcpf(d2.y);
                        const f32x2 o2 = t2 * r2;
                        wv[h] = cvt_pk_bf16(o2.x, o2.y); }
                    w.x = wv[0]; w.y = wv[1]; w.z = wv[2]; w.w = wv[3];
                }
                *(u32x4*)(O + (size_t)(row0 + ai * HALF + m * 16) * FF + col0) = w;
            }
        ZERO_ACC();
    }
};
struct EpiM {
    static constexpr bool PERM = true, FUSED = true;
    float* P; bf16_t* XB; float* RS; float* OUT; const float* gpost; float cpost; float* X1; float* X2; unsigned* cnt1; unsigned* cnt2; int final_out;
    __device__ __forceinline__ void operator()(f32x4 (&acc)[2][2][4][2], const Unit& u, int wr, int wc, int fr, int fq) const {
        const int row0 = u.pm * BM + wr * 64 + fr, col0 = u.pn * BM + wc * 32 + 8 * fq;
        float* base = P + (size_t)u.sp * TS * D - (size_t)TP * D;
#pragma unroll
        for (int ai = 0; ai < 2; ++ai)
#pragma unroll
            for (int m = 0; m < 4; ++m) { float* rowp = base + (size_t)(row0 + ai * HALF + m * 16) * D + col0;
#pragma unroll
                for (int bj = 0; bj < 2; ++bj) { *(f32x4*)(rowp + bj * HALF) = acc[ai][bj][m][0]; *(f32x4*)(rowp + bj * HALF + 4) = acc[ai][bj][m][1]; } }
        ZERO_ACC();
    }
    __device__ __forceinline__ void row_sumsq(const f32x4 (&acc)[2][2][4][2], const Unit& u, int wr, int wc, int fr, int fq, LAS unsigned char* lds, float* X, unsigned* cnt) const {
        LAS float* Pt = (LAS float*)lds;
        LAS float* S = (LAS float*)(lds + 4096);
#pragma unroll
        for (int ai = 0; ai < 2; ++ai)
#pragma unroll
            for (int m = 0; m < 4; ++m) { float q = 0.f;
#pragma unroll
                for (int bj = 0; bj < 2; ++bj)
#pragma unroll
                    for (int n = 0; n < 2; ++n) { const f32x4 x = acc[ai][bj][m][n]; q += (x[0] * x[0] + x[1] * x[1]) + (x[2] * x[2] + x[3] * x[3]); }
                q += __shfl_xor(q, 16); q += __shfl_xor(q, 32);
                if (fq == 0) Pt[(ai * HALF + wr * 64 + m * 16 + fr) * 4 + wc] = q; }
        asm volatile("s_waitcnt lgkmcnt(0)" ::: "memory"); __builtin_amdgcn_s_barrier(); asm volatile("" ::: "memory");
        const int t = threadIdx.x;
        if (t < 256) { const float tot = (Pt[t * 4 + 0] + Pt[t * 4 + 1]) + (Pt[t * 4 + 2] + Pt[t * 4 + 3]);
            __hip_atomic_store(X + ((size_t)(u.pm * BM + t) * 4 + u.pn), tot, __ATOMIC_RELAXED, __HIP_MEMORY_SCOPE_AGENT); }
        asm volatile("s_waitcnt vmcnt(0)" ::: "memory");
        if (t < 256 && (t & 63) == 0) __hip_atomic_fetch_add(cnt, 1u, __ATOMIC_RELAXED, __HIP_MEMORY_SCOPE_AGENT);
        if (t < 64) { unsigned sp_ = 0;
            while ((unsigned)__builtin_amdgcn_readfirstlane(__hip_atomic_load(cnt, __ATOMIC_RELAXED, __HIP_MEMORY_SCOPE_AGENT)) < 16u) { __builtin_amdgcn_s_sleep(1); if (++sp_ > (1u << 22)) break; } }
        asm volatile("s_waitcnt vmcnt(0) lgkmcnt(0)" ::: "memory"); __builtin_amdgcn_s_barrier(); asm volatile("" ::: "memory");
        if (t < 256) { const float* xs = X + (size_t)(u.pm * BM + t) * 4; float tot = 0.f;
#pragma unroll
            for (int k = 0; k < 4; ++k) tot += __hip_atomic_load(xs + k, __ATOMIC_RELAXED, __HIP_MEMORY_SCOPE_AGENT);
            S[t] = tot; }
        asm volatile("s_waitcnt vmcnt(0) lgkmcnt(0)" ::: "memory"); __builtin_amdgcn_s_barrier(); asm volatile("" ::: "memory");
    }
    __device__ __forceinline__ void fused(f32x4 (&acc)[2][2][4][2], const Unit& u, int wr, int wc, int fr, int fq, LAS unsigned char* lds) const {
        const LAS float* S = (const LAS float*)(lds + 4096);
        const int col0 = u.pn * BM + wc * 32 + 8 * fq;
        unsigned* c1 = cnt1 + 16 * u.pm; unsigned* c2 = cnt2 + 16 * u.pm;
        row_sumsq(acc, u, wr, wc, fr, fq, lds, X1, c1);
        float g8[2][8]; load8f(gpost + col0, g8[0]); load8f(gpost + col0 + HALF, g8[1]);
#pragma unroll
        for (int ai = 0; ai < 2; ++ai)
#pragma unroll
            for (int m = 0; m < 4; ++m) { const int r = ai * HALF + wr * 64 + m * 16 + fr; const float rs = cpost * rsqrtf(S[r] * (1.0f / D) + EPS);
#pragma unroll
                for (int bj = 0; bj < 2; ++bj) { float xb[8]; load8bf(XB + (size_t)(u.pm * BM + r) * D + col0 + bj * HALF, xb);
#pragma unroll
                    for (int j = 0; j < 4; ++j) { acc[ai][bj][m][0][j] = xb[j] + acc[ai][bj][m][0][j] * rs * g8[bj][j]; acc[ai][bj][m][1][j] = xb[4 + j] + acc[ai][bj][m][1][j] * rs * g8[bj][4 + j]; } } }
        if (final_out) {
#pragma unroll
            for (int ai = 0; ai < 2; ++ai)
#pragma unroll
                for (int m = 0; m < 4; ++m) { float* rowp = OUT + (size_t)(u.pm * BM + ai * HALF + wr * 64 + m * 16 + fr) * D + col0;
#pragma unroll
                    for (int bj = 0; bj < 2; ++bj) { *(f32x4*)(rowp + bj * HALF) = acc[ai][bj][m][0]; *(f32x4*)(rowp + bj * HALF + 4) = acc[ai][bj][m][1]; } }
            return;
        }
        asm volatile("s_waitcnt lgkmcnt(0)" ::: "memory"); __builtin_amdgcn_s_barrier(); asm volatile("" ::: "memory");
        row_sumsq(acc, u, wr, wc, fr, fq, lds, X2, c2);
        if (u.pn == 0 && threadIdx.x < 256) RS[u.pm * BM + threadIdx.x] = rsqrtf(S[threadIdx.x] * (1.0f / D) + EPS);
#pragma unroll
        for (int ai = 0; ai < 2; ++ai)
#pragma unroll
            for (int m = 0; m < 4; ++m) { bf16_t* rowp = XB + (size_t)(u.pm * BM + ai * HALF + wr * 64 + m * 16 + fr) * D + col0;
#pragma unroll
                for (int bj = 0; bj < 2; ++bj) { const f32x4 v0 = acc[ai][bj][m][0], v1 = acc[ai][bj][m][1];
                    u32x4 w; w.x = cvt_pk_bf16(v0[0], v0[1]); w.y = cvt_pk_bf16(v0[2], v0[3]); w.z = cvt_pk_bf16(v1[0], v1[1]); w.w = cvt_pk_bf16(v1[2], v1[3]);
                    *(u32x4*)(rowp + bj * HALF) = w; } }
    }
};
struct EpiMix {
    static constexpr bool PERM = true, FUSED = false;
    bf16_t* O; const float* RS;
    __device__ __forceinline__ void operator()(f32x4 (&acc)[2][2][4][2], const Unit& u, int wr, int wc, int fr, int fq) const {
        const int row0 = u.pm * BM + wr * 64 + fr, col0 = u.pn * BM + wc * 32 + 8 * fq;
        const int kind = u.pn < 4 ? 0 : (u.pn < 12 ? 1 : 2);
#pragma unroll
        for (int ai = 0; ai < 2; ++ai)
#pragma unroll
            for (int m = 0; m < 4; ++m) { bf16_t* rowp = O + (size_t)(row0 + ai * HALF + m * 16) * DIN + col0; const float rs = RS[row0 + ai * HALF + m * 16];
#pragma unroll
                for (int bj = 0; bj < 2; ++bj) { f32x4 v0 = acc[ai][bj][m][0] * rs, v1 = acc[ai][bj][m][1] * rs;
                    if (kind == 0) {
#pragma unroll
                        for (int j = 0; j < 4; ++j) { v0[j] = fgelu(v0[j]); v1[j] = fgelu(v1[j]); } }
                    else if (kind == 2) {
#pragma unroll
                        for (int j = 0; j < 4; ++j) { v0[j] = fsigmoid(v0[j]); v1[j] = fsigmoid(v1[j]); } }
                    u32x4 w; w.x = cvt_pk_bf16(v0[0], v0[1]); w.y = cvt_pk_bf16(v0[2], v0[3]); w.z = cvt_pk_bf16(v1[0], v1[1]); w.w = cvt_pk_bf16(v1[2], v1[3]);
                    *(u32x4*)(rowp + bj * HALF) = w; } }
        ZERO_ACC();
    }
};
struct EpiBranch {
    static constexpr bool PERM = true, FUSED = false;
    const bf16_t* G;
    bf16_t* O;
    bf16_t* O2;
    __device__ __forceinline__ void operator()(f32x4 (&acc)[2][2][4][2], const Unit& u, int wr, int wc, int fr, int fq) const {
        const int row0 = u.pm * BM + wr * 64 + fr, col0 = u.pn * BM + wc * 32 + 8 * fq;
        const int sub = u.sub;
#pragma unroll
        for (int ai = 0; ai < 2; ++ai)
#pragma unroll
            for (int m = 0; m < 4; ++m) { const size_t row = (size_t)(row0 + ai * HALF + m * 16);
#pragma unroll
                for (int bj = 0; bj < 2; ++bj) {
                    const bf16_t* gp = G + row * DIN + col0 + bj * HALF;
                    if (sub < 2) {
                        float gn[8], gd[8]; load8bf(gp + sub * D, gn); load8bf(gp + (sub + 1) * D, gd);
#pragma unroll
                        for (int j = 0; j < 4; ++j) { acc[ai][bj][m][0][j] *= gn[j] * __builtin_amdgcn_rcpf(fmaxf(gd[j], 1e-30f)); acc[ai][bj][m][1][j] *= gn[4 + j] * __builtin_amdgcn_rcpf(fmaxf(gd[4 + j], 1e-30f)); }
                    } else {
                        float gn[8]; load8bf(gp + 2 * D, gn);
                        const f32x4 v0 = acc[ai][bj][m][0], v1 = acc[ai][bj][m][1];
                        u32x4 w; w.x = cvt_pk_bf16(v0[0] * gn[0], v0[1] * gn[1]); w.y = cvt_pk_bf16(v0[2] * gn[2], v0[3] * gn[3]); w.z = cvt_pk_bf16(v1[0] * gn[4], v1[1] * gn[5]); w.w = cvt_pk_bf16(v1[2] * gn[6], v1[3] * gn[7]);
                        if (u.pm < 64) *(u32x4*)(O + row * D + col0 + bj * HALF) = w;
                        else *(u32x4*)(O2 + (size_t)u.sp * TS * D + (row - TP) * D + col0 + bj * HALF) = w;
                        acc[ai][bj][m][0] = (f32x4){0.f, 0.f, 0.f, 0.f}; acc[ai][bj][m][1] = (f32x4){0.f, 0.f, 0.f, 0.f};
                    } } }
    }
};

template <class Epi>
__device__ __forceinline__ void gemm_phase(LAS unsigned char* lds, const int K, const Sched& S, const Epi& E) {
    int tid_ = threadIdx.x; asm volatile("" : "+v"(tid_));
    const int tid = tid_, wid = __builtin_amdgcn_readfirstlane(tid >> 6), lane = tid & 63, wr = wid >> 2, wc = wid & 3, fr = lane & 15, fq = lane >> 4;
    unsigned voffA[2], voffB[2];
#pragma unroll
    for (int i = 0; i < 2; ++i) { int R, C; stage_rc(tid * 16 + i * 8192, R, C); const int Rb = Epi::PERM ? ((R & ~31) + perm32(R & 31)) : R;
        voffA[i] = (unsigned)(R * K + C) * 2u; voffB[i] = (unsigned)(Rb * K + C) * 2u; }
    const size_t kstep = (size_t)(BK * 2);
    const size_t hstep = (size_t)HALF * K * 2;
    const unsigned ldsw = (unsigned)wid * 1024u;
    const int aoff = lds_byte(wr * 64 + fr, fq * 8), boff = lds_byte(wc * 32 + fr, fq * 8);
#define PG8_SA(b, h) (((b) * 2 + (h)) * HTB)
#define PG8_SB(b, h) ((4 + (b) * 2 + (h)) * HTB)
#define PG8_STAGE(bufoff, gbase, voff) do { _Pragma("unroll") for (int _i = 0; _i < 2; ++_i) \
        __builtin_amdgcn_global_load_lds((const unsigned*)((const char*)(gbase) + (voff)[_i]), (LAS unsigned*)(lds + (bufoff) + ldsw + _i * 8192), 16, 0, 0); } while (0)
#define PG8_LDA(dst, b, h) do { _Pragma("unroll") for (int m = 0; m < 4; ++m) _Pragma("unroll") for (int k = 0; k < 2; ++k) dst[m][k] = *(const LAS bf16x8*)(lds + PG8_SA(b, h) + aoff + m * 2048 + k * 1024); } while (0)
#define PG8_LDB(dst, b, h) do { _Pragma("unroll") for (int n = 0; n < 2; ++n) _Pragma("unroll") for (int k = 0; k < 2; ++k) dst[n][k] = *(const LAS bf16x8*)(lds + PG8_SB(b, h) + boff + n * 2048 + k * 1024); } while (0)
#define PG8_MMA(ai, bj, At, Bt) do { __builtin_amdgcn_s_setprio(1); _Pragma("unroll") for (int m = 0; m < 4; ++m) _Pragma("unroll") for (int n = 0; n < 2; ++n) _Pragma("unroll") for (int k = 0; k < 2; ++k) \
        acc[ai][bj][m][n] = __builtin_amdgcn_mfma_f32_16x16x32_bf16(Bt[n][k], At[m][k], acc[ai][bj][m][n], 0, 0, 0); __builtin_amdgcn_s_setprio(0); } while (0)
#define PG8_WAIT_V(n) asm volatile("s_waitcnt vmcnt(" #n ")" ::: "memory")
#define PG8_WAIT_L(n) asm volatile("s_waitcnt lgkmcnt(" #n ")" ::: "memory")
#define PG8_BAR __builtin_amdgcn_s_barrier()
#define PG8_SCHED __builtin_amdgcn_sched_barrier(0)
    Unit cur, nxt; int ui = 0;
    if (!S.next(0, cur)) return;
    f32x4 acc[2][2][4][2];
    ZERO_ACC();
    bf16x8 At[4][2], B0[2][2], B1[2][2];
    const char* cA = cur.A; const char* cB = cur.B;
    S.a_ready(cur);
    PG8_STAGE(PG8_SB(0, 0), cB, voffB); PG8_STAGE(PG8_SB(0, 1), cB + hstep, voffB); PG8_STAGE(PG8_SA(0, 0), cA, voffA); PG8_STAGE(PG8_SA(0, 1), cA + hstep, voffA);
    PG8_STAGE(PG8_SB(1, 0), cB + kstep, voffB); PG8_STAGE(PG8_SA(1, 0), cA + kstep, voffA); PG8_STAGE(PG8_SB(1, 1), cB + hstep + kstep, voffB);
    if (wr == 1) PG8_BAR;
    PG8_WAIT_V(8); PG8_BAR;
    PG8_WAIT_V(6); PG8_BAR;
    for (;;) {
        const bool has_next = S.next(ui + 1, nxt);
        const char* nA = has_next ? nxt.A : cA; const char* nB = has_next ? nxt.B : cB;
        const int nt = cur.nt;
        for (int t = 0; t < nt; t += 2) {
            const bool last = (t == nt - 2);
            const char* a1 = cA + (size_t)(t + 1) * kstep;
            const char* a2 = last ? nA : cA + (size_t)(t + 2) * kstep; const char* b2 = last ? nB : cB + (size_t)(t + 2) * kstep;
            const char* a3 = a2 + kstep; const char* b3 = b2 + kstep;
            if (last && has_next) S.a_ready(nxt);
            PG8_LDB(B0, 0, 0); PG8_LDB(B1, 0, 1); PG8_SCHED; PG8_LDA(At, 0, 0); PG8_STAGE(PG8_SA(1, 1), a1 + hstep, voffA);
            PG8_WAIT_V(8); PG8_WAIT_L(0); PG8_BAR; PG8_MMA(0, 0, At, B0); PG8_MMA(0, 1, At, B1); PG8_BAR; PG8_SCHED;
            PG8_LDA(At, 0, 1); PG8_STAGE(PG8_SB(0, 0), b2, voffB); PG8_STAGE(PG8_SB(0, 1), b2 + hstep, voffB); PG8_STAGE(PG8_SA(0, 0), a2, voffA);
            PG8_WAIT_V(8); PG8_WAIT_L(0); PG8_BAR; PG8_MMA(1, 0, At, B0); PG8_MMA(1, 1, At, B1); PG8_BAR; PG8_SCHED;
            PG8_LDB(B0, 1, 0); PG8_LDB(B1, 1, 1); PG8_SCHED; PG8_LDA(At, 1, 0); PG8_STAGE(PG8_SA(0, 1), a2 + hstep, voffA);
            PG8_WAIT_V(8); PG8_WAIT_L(0); PG8_BAR; PG8_MMA(0, 0, At, B0); PG8_MMA(0, 1, At, B1); PG8_BAR; PG8_SCHED;
            PG8_LDA(At, 1, 1); PG8_STAGE(PG8_SB(1, 0), b3, voffB); PG8_STAGE(PG8_SB(1, 1), b3 + hstep, voffB); PG8_STAGE(PG8_SA(1, 0), a3, voffA);
            PG8_WAIT_V(8); PG8_WAIT_L(0); PG8_BAR; PG8_MMA(1, 0, At, B0); PG8_MMA(1, 1, At, B1); PG8_BAR; PG8_SCHED;
        }
        if (wr == 0) PG8_BAR;
        if (!(Epi::FUSED && !has_next)) E(acc, cur, wr, wc, fr, fq);
        if (!has_next) break;
        cur = nxt; cA = nA; cB = nB; ++ui;
        if (wr == 1) PG8_BAR;
    }
    PG8_WAIT_V(0);
    PG8_BAR;
    if constexpr (Epi::FUSED) E.fused(acc, cur, wr, wc, fr, fq, lds);
#undef PG8_SA
#undef PG8_SB
#undef PG8_STAGE
#undef PG8_LDA
#undef PG8_LDB
#undef PG8_MMA
#undef PG8_WAIT_V
#undef PG8_WAIT_L
#undef PG8_BAR
#undef PG8_SCHED
}

__device__ __forceinline__ void transpose_item(const float* W, int K, int N, bf16_t* WT, LAS float* scr, int item, int lane, bool gu_map, const float* gk) {
    const int nblk = N / 32, kb = item / nblk, nb = item % nblk, k0 = 64 * kb, n0 = 32 * nb;
    int s0 = n0;
    if (gu_map) { const int pn = n0 >> 8, w = n0 & 255; s0 = (w < 128) ? pn * 128 + w : FF + pn * 128 + (w - 128); }
    {
        f32x4 v[8]; float gg[8];
#pragma unroll
        for (int i = 0; i < 8; ++i) { const int kk = (lane >> 3) + 8 * i; v[i] = *(const f32x4*)(W + (size_t)(k0 + kk) * N + s0 + (lane & 7) * 4); gg[i] = gk ? gk[k0 + kk] : 1.0f; }
#pragma unroll
        for (int i = 0; i < 8; ++i) { const int kk = (lane >> 3) + 8 * i; LAS float* d = scr + kk * 33 + (lane & 7) * 4;
            d[0] = v[i][0] * gg[i]; d[1] = v[i][1] * gg[i]; d[2] = v[i][2] * gg[i]; d[3] = v[i][3] * gg[i]; }
    }
    asm volatile("s_waitcnt lgkmcnt(0)" ::: "memory");
    const int c = lane & 7;
#pragma unroll
    for (int j = 0; j < 4; ++j) { const int n = (lane >> 3) + 8 * j; const LAS float* s = scr + (8 * c) * 33 + n;
        u32x4 o; o.x = cvt_pk_bf16(s[0 * 33], s[1 * 33]); o.y = cvt_pk_bf16(s[2 * 33], s[3 * 33]); o.z = cvt_pk_bf16(s[4 * 33], s[5 * 33]); o.w = cvt_pk_bf16(s[6 * 33], s[7 * 33]);
        *(u32x4*)(WT + (size_t)(n0 + n) * K + k0 + 8 * c) = o; }
    asm volatile("s_waitcnt lgkmcnt(0)" ::: "memory");
}

constexpr int PREP_I_GU = 16 * 176, PREP_I_DN = 44 * 32, PREP_I_IN = 16 * 192, PREP_I_BR = 8 * 32, PREP_I_O = 16 * 32;
constexpr int PREP_PER_L = 2 * PREP_I_GU + 2 * PREP_I_DN + PREP_I_IN + 2 * PREP_I_BR + PREP_I_O;
__device__ __forceinline__ void prep_layer(const Params& p, int l, LAS unsigned char* lds, int wid, int lane, int worker, int n_workers, int it0, int it1) {
    LAS float* scr = (LAS float*)(lds + wid * 16384);
    for (int it = it0 + worker; it < it1; it += n_workers) {
        int r = it;
        if (r < 2 * PREP_I_GU) { const int j = r / PREP_I_GU; r -= j * PREP_I_GU;
            transpose_item(p.wgu + (size_t)(l * 2 + j) * D * 2 * FF, D, 2 * FF, (bf16_t*)(p.ws + WS_WGU + (size_t)(l * 2 + j) * SZ_WGU), scr, r, lane, true, p.ng + (size_t)(l * 6 + (j == 0 ? 0 : 4)) * D); continue; }
        r -= 2 * PREP_I_GU;
        if (r < 2 * PREP_I_DN) { const int j = r / PREP_I_DN; r -= j * PREP_I_DN;
            transpose_item(p.wdn + (size_t)(l * 2 + j) * FF * D, FF, D, (bf16_t*)(p.ws + WS_WDN + (size_t)(l * 2 + j) * SZ_WDN), scr, r, lane, false, nullptr); continue; }
        r -= 2 * PREP_I_DN;
        if (r < PREP_I_IN) { transpose_item(p.win + (size_t)l * D * DIN, D, DIN, (bf16_t*)(p.ws + WS_WIN + (size_t)l * SZ_WIN), scr, r, lane, false, p.ng + (size_t)(l * 6 + 2) * D); continue; }
        r -= PREP_I_IN;
        if (r < PREP_I_BR) { transpose_item(p.wa + (size_t)l * 512 * D, 512, D, (bf16_t*)(p.ws + WS_WA + (size_t)l * SZ_WBR), scr, r, lane, false, nullptr); continue; }
        r -= PREP_I_BR;
        if (r < PREP_I_BR) { transpose_item(p.wb + (size_t)l * 512 * D, 512, D, (bf16_t*)(p.ws + WS_WB + (size_t)l * SZ_WBR), scr, r, lane, false, nullptr); continue; }
        r -= PREP_I_BR;
        transpose_item(p.wo + (size_t)l * D * D, D, D, (bf16_t*)(p.ws + WS_WO + (size_t)l * SZ_WO), scr, r, lane, false, nullptr);
    }
}
constexpr int PREP_W1 = 1363, PREP_W2 = 6090, PREP_W3 = 11180;
__device__ __forceinline__ void fold_items(const Params& p, LAS unsigned char* lds, int tid, int it0, int it1, int worker_wg, int n_wg);
__device__ __forceinline__ void prep_window(const Params& p, int l, int w, LAS unsigned char* lds, int worker_wg, int n_wg) {
    int tid = threadIdx.x; asm volatile("" : "+v"(tid));
    const int wid = __builtin_amdgcn_readfirstlane(tid >> 6), lane = tid & 63;
    const int wk = worker_wg * NWAVES + wid, nw = n_wg * NWAVES;
    if (l + 1 < DEPTH) { const int i0 = w == 0 ? 0 : (w == 1 ? PREP_W1 : (w == 2 ? PREP_W2 : PREP_W3)), i1 = w == 0 ? PREP_W1 : (w == 1 ? PREP_W2 : (w == 2 ? PREP_W3 : PREP_PER_L));
        prep_layer(p, l + 1, lds, wid, lane, wk, nw, i0, i1); }
    if (l == 0 && w == 1) prep_layer(p, 0, lds, wid, lane, wk, nw, PREP_I_GU, 2 * PREP_I_GU);
    if (l == 0 && w == 2) prep_layer(p, 0, lds, wid, lane, wk, nw, 2 * PREP_I_GU + PREP_I_DN, 2 * PREP_I_GU + 2 * PREP_I_DN);
    __syncthreads();
    if (l == 0 && w == 0) fold_items(p, lds, tid, 0, 64, worker_wg, n_wg);
    if (w == 2 && l + 1 < DEPTH) fold_items(p, lds, tid, 64 * (l + 1), 64 * (l + 2), worker_wg, n_wg);
}

__device__ __forceinline__ void fold_items(const Params& p, LAS unsigned char* lds, int tid, int it0, int it1, int worker_wg, int n_wg) {
    LAS float* wp = (LAS float*)lds;
    LAS float* wcs = (LAS float*)(lds + 65536);
    for (int it = it0 + worker_wg; it < it1; it += n_wg) {
        const int l = it >> 6, g = (it >> 4) & 3, n0 = (it & 15) * 64;
        const float* wpg = p.wpool + (size_t)(l * 4 + g) * 128 * 128;
        for (int i = tid; i < 128 * 128 / 4; i += NTHREADS) *(LAS f32x4*)(wp + i * 4) = *(const f32x4*)(wpg + i * 4);
        for (int i = tid; i < 128 * 64 / 4; i += NTHREADS) { const int d = i >> 4, n4 = (i & 15) * 4;
            const float sc = p.pscale[l * 512 + g * 128 + d];
            f32x4 v = *(const f32x4*)(p.wc + ((size_t)l * 512 + g * 128 + d) * D + n0 + n4);
            *(LAS f32x4*)(wcs + d * 64 + n4) = v * sc; }
        __syncthreads();
        const int n = tid & 63, cgp = tid >> 6;
        float a[16];
#pragma unroll
        for (int i = 0; i < 16; ++i) a[i] = 0.f;
        for (int d = 0; d < 128; ++d) { const float wv = wcs[d * 64 + n];
#pragma unroll
            for (int i = 0; i < 16; ++i) a[i] += wp[(16 * cgp + i) * 128 + d] * wv; }
        bf16_t* o = (bf16_t*)(p.ws + WS_WC) + (size_t)l * 1024 * 512 + (size_t)(n0 + n) * 512 + g * 128 + 16 * cgp;
        u32x4 w0, w1;
        w0.x = cvt_pk_bf16(a[0], a[1]); w0.y = cvt_pk_bf16(a[2], a[3]); w0.z = cvt_pk_bf16(a[4], a[5]); w0.w = cvt_pk_bf16(a[6], a[7]);
        w1.x = cvt_pk_bf16(a[8], a[9]); w1.y = cvt_pk_bf16(a[10], a[11]); w1.z = cvt_pk_bf16(a[12], a[13]); w1.w = cvt_pk_bf16(a[14], a[15]);
        *(u32x4*)o = w0; *(u32x4*)(o + 8) = w1;
        __syncthreads();
    }
}
__device__ __forceinline__ void prep_phase(const Params& p, LAS unsigned char* lds, int tid, int wid, int lane) {
    { const int w = blockIdx.x * NWAVES + wid, nw = gridDim.x * NWAVES;
      prep_layer(p, 0, lds, wid, lane, w, nw, 0, PREP_I_GU); prep_layer(p, 0, lds, wid, lane, w, nw, 2 * PREP_I_GU, 2 * PREP_I_GU + PREP_I_DN); prep_layer(p, 0, lds, wid, lane, w, nw, 2 * PREP_I_GU + 2 * PREP_I_DN, PREP_PER_L); }
    __syncthreads();
}

template <int NR>
__device__ __forceinline__ void norm_rows(const Params& p, int mode, float cpost, const float* gpost, int nsplit, int row0, int rstride, int nvalid, int lane, bool dry) {
    bf16_t* XB = (bf16_t*)(p.ws + WS_H); const bf16_t* Mb = (const bf16_t*)(p.ws + WS_M); float* RS = (float*)(p.ws + WS_RS);
    float v[NR][2][8], mm[NR][2][8];
#pragma unroll
    for (int k = 0; k < NR; ++k) { const int row = row0 + (k < nvalid ? k : 0) * rstride;
        if (mode == 0) { const float* src = (row < TP ? p.xp + (size_t)row * D : p.xs + (size_t)(row - TP) * D);
#pragma unroll
            for (int j = 0; j < 2; ++j) load8f(src + lane * 8 + 512 * j, v[k][j]); }
        else {
#pragma unroll
            for (int j = 0; j < 2; ++j) load8bf(XB + (size_t)row * D + lane * 8 + 512 * j, v[k][j]);
#pragma unroll
            for (int j = 0; j < 2; ++j) {
                if (row < TP) load8bf(Mb + (size_t)row * D + lane * 8 + 512 * j, mm[k][j]);
                else { const float* pp = (const float*)(p.ws + WS_P) + (size_t)(row - TP) * D + lane * 8 + 512 * j; load8f(pp, mm[k][j]);
                    if constexpr (NR == 1) {
#pragma unroll
                        for (int sp = 1; sp < 11; ++sp) { const int spc = sp < nsplit ? sp : 0; const float msk = sp < nsplit ? 1.0f : 0.0f; float t8[8]; load8f(pp + (size_t)spc * TS * D, t8);
#pragma unroll
                            for (int e = 0; e < 8; ++e) mm[k][j][e] += msk * t8[e]; }
                    } else {
                        for (int sp = 1; sp < nsplit; ++sp) { float t8[8]; load8f(pp + (size_t)sp * TS * D, t8);
#pragma unroll
                            for (int e = 0; e < 8; ++e) mm[k][j][e] += t8[e]; } } } }
        } }
    float g8[2][8];
    if (mode != 0) { load8f(gpost + lane * 8, g8[0]); load8f(gpost + lane * 8 + 512, g8[1]); }
#pragma unroll
    for (int k = 0; k < NR; ++k) { const int row = row0 + (k < nvalid ? k : 0) * rstride;
        if (mode != 0) { float ss = 0.f;
#pragma unroll
            for (int j = 0; j < 2; ++j)
#pragma unroll
                for (int e = 0; e < 8; ++e) ss += mm[k][j][e] * mm[k][j][e];
            const float rs = cpost * rsqrtf(wave_sum(ss) * (1.0f / D) + EPS);
#pragma unroll
            for (int j = 0; j < 2; ++j)
#pragma unroll
                for (int e = 0; e < 8; ++e) v[k][j][e] += mm[k][j][e] * rs * g8[j][e]; }
        if (k < nvalid) {
            if (mode == 2) {
#pragma unroll
                for (int j = 0; j < 2; ++j) store8f(p.out + (size_t)row * D + lane * 8 + 512 * j, v[k][j]);
            } else {
                float ss = 0.f;
#pragma unroll
                for (int j = 0; j < 2; ++j) {
                    store16((dry ? (bf16_t*)(p.ws + WS_MG) : XB) + (size_t)row * D + lane * 8 + 512 * j, pack8(v[k][j]), NR == 1);
#pragma unroll
                    for (int e = 0; e < 8; ++e) ss += v[k][j][e] * v[k][j][e]; }
                const float rs = rsqrtf(wave_sum(ss) * (1.0f / D) + EPS);
                if (lane == 0) { if (NR == 1) __hip_atomic_store((dry ? (float*)(p.ws + WS_AIN) : RS) + row, rs, __ATOMIC_RELAXED, __HIP_MEMORY_SCOPE_AGENT); else (dry ? (float*)(p.ws + WS_AIN) : RS)[row] = rs; }
            } } }
}
__device__ __forceinline__ void norm_phase(const Params& p, int mode, float cpost, const float* gpost, int nsplit, int wid, int lane, bool dry = false, bool sample_only = false) {
    const int gw = blockIdx.x * NWAVES + wid, NGW = gridDim.x * NWAVES;
    if (!sample_only) for (int row = gw; row < TP; row += 4 * NGW) { const int left = (TP - row + NGW - 1) / NGW; norm_rows<4>(p, mode, cpost, gpost, nsplit, row, NGW, left < 4 ? left : 4, lane, dry); }
    for (int row = TP + gw; row < T; row += NGW) norm_rows<1>(p, mode, cpost, gpost, nsplit, row, NGW, 1, lane, dry);
}

__device__ __forceinline__ void sample_norm_head(const Params& p, float cpost, const float* gpost, int nsplit, unsigned* cnt, int c, int G) {
    if (c >= G - 64) {
        int tid = threadIdx.x; asm volatile("" : "+v"(tid));
        const int wid = __builtin_amdgcn_readfirstlane(tid >> 6), lane = tid & 63;
        norm_rows<1>(p, 1, cpost, gpost, nsplit, TP + (c - (G - 64)) * NWAVES + wid, 0, 1, lane, false);
        asm volatile("s_waitcnt vmcnt(0)" ::: "memory"); __syncthreads();
        if (threadIdx.x == 0) __hip_atomic_fetch_add(cnt, 1u, __ATOMIC_RELAXED, __HIP_MEMORY_SCOPE_AGENT);
    }
}

template <int W>
__device__ __forceinline__ void bc_group(const Params& p, int l, bool smp, size_t rg, int ch, const bf16_t* MIX, bf16_t* BIN, bf16_t* CIN) {
    constexpr int NP = W - 1 + 4;
    int t0, b; if (!smp) { t0 = (int)(rg & 2047); b = (int)(rg >> 11); } else { t0 = 0; b = ((int)rg - TP) >> 2; }
    const bf16_t* mr = MIX + rg * DIN;
    u32x4 praw[NP];
    float Z[6][8];
    u32x4 graw[4];
    {
        u32x4 xraw[6], craw[6];
#pragma unroll
        for (int j = -(W - 1); j <= 3; ++j) { const int jj = (j >= 0 || t0 + j >= 0) ? j : 0; praw[j + W - 1] = *(const u32x4*)(mr + (ptrdiff_t)jj * DIN + 2560 + ch); }
#pragma unroll
        for (int j = -2; j <= 3; ++j) { const int jj = (j >= 0 || t0 + j >= 0) ? j : 0; xraw[j + 2] = *(const u32x4*)(mr + (ptrdiff_t)jj * DIN + 1024 + ch); craw[j + 2] = *(const u32x4*)(mr + (ptrdiff_t)jj * DIN + 2048 + ch); }
#pragma unroll
        for (int i = 0; i < 4; ++i) graw[i] = *(const u32x4*)(mr + (size_t)i * DIN + 1536 + ch);
#pragma unroll
        for (int j = -(W - 1); j < 0; ++j) { if (t0 + j < 0) praw[j + W - 1] = (u32x4){0u, 0u, 0u, 0u}; }
#pragma unroll
        for (int j = -2; j <= 3; ++j) { const float msk = (j >= 0 || t0 + j >= 0) ? 1.0f : 0.0f; float xv[8], cv[8]; unpack8(xraw[j + 2], xv); unpack8(craw[j + 2], cv);
#pragma unroll
            for (int e = 0; e < 8; ++e) Z[j + 2][e] = (j < 0 ? msk : 1.0f) * xv[e] * cv[e]; }
    }
    if (smp) {
        const float* sp = p.spool + ((size_t)(l * 128 + b) * 15) * 512 + ch;
#pragma unroll
        for (int j = -(W - 1); j < 0; ++j) { float t8[8]; load8f(sp + (size_t)(15 + j) * 512, t8); praw[j + W - 1] = pack8(t8); }
        const float* sc = p.sconv + ((size_t)(l * 128 + b) * 2) * 512 + ch;
        load8f(sc, Z[0]); load8f(sc + 512, Z[1]);
    }
    {
        float w0[8], w1[8], w2[8]; load8f(p.wconv + (l * 3 + 0) * 512 + ch, w0); load8f(p.wconv + (l * 3 + 1) * 512 + ch, w1); load8f(p.wconv + (l * 3 + 2) * 512 + ch, w2);
#pragma unroll
        for (int i = 0; i < 4; ++i) { float o[8], gv[8]; unpack8(graw[i], gv);
#pragma unroll
            for (int e = 0; e < 8; ++e) o[e] = gv[e] * (w0[e] * Z[i][e] + w1[e] * Z[i + 1][e] + w2[e] * Z[i + 2][e]);
            *(u32x4*)(BIN + (rg + i) * 512 + ch) = pack8(o); }
    }
    if (!smp) { if (t0 == PAST_T - 4) { store8f(p.out + O_CONV_P + ((size_t)(l * 8 + b) * 2 + 0) * 512 + ch, Z[4]); store8f(p.out + O_CONV_P + ((size_t)(l * 8 + b) * 2 + 1) * 512 + ch, Z[5]); } }
    else { store8f(p.out + O_CONV_S + ((size_t)(l * 128 + b) * 2 + 0) * 512 + ch, Z[4]); store8f(p.out + O_CONV_S + ((size_t)(l * 128 + b) * 2 + 1) * 512 + ch, Z[5]); }
    float sm[8];
#pragma unroll
    for (int e = 0; e < 8; ++e) sm[e] = 0.f;
#pragma unroll
    for (int j = -(W - 1); j <= 0; ++j) { float pv[8]; unpack8(praw[j + W - 1], pv);
#pragma unroll
        for (int e = 0; e < 8; ++e) sm[e] += pv[e]; }
#pragma unroll
    for (int i = 0; i < 4; ++i) {
        float pi[8]; unpack8(praw[i + W - 1], pi);
        if (i > 0) { float po[8]; unpack8(praw[i - 1], po);
#pragma unroll
            for (int e = 0; e < 8; ++e) sm[e] += pi[e] - po[e]; }
        const float inv = 1.0f / (float)(smp ? W : (t0 + i + 1 < W ? t0 + i + 1 : W));
        float o[8];
#pragma unroll
        for (int e = 0; e < 8; ++e) o[e] = sm[e] * inv - pi[e];
        *(u32x4*)(CIN + (rg + i) * 512 + ch) = pack8(o);
        if (!smp) { const int t = t0 + i; if (t >= PAST_T - 15) store8f(p.out + O_POOL_P + ((size_t)(l * 8 + b) * 15 + (t - (PAST_T - 15))) * 512 + ch, pi); }
        else store8f(p.out + O_POOL_S + ((size_t)(l * 128 + b) * 15 + 11 + i) * 512 + ch, pi);
    }
    if (smp) {
        const float* sp = p.spool + ((size_t)(l * 128 + b) * 15) * 512 + ch;
#pragma unroll
        for (int jr = 0; jr < 11; ++jr) { float cp[8]; load8f(sp + (size_t)(jr + 4) * 512, cp); store8f(p.out + O_POOL_S + ((size_t)(l * 128 + b) * 15 + jr) * 512 + ch, cp); }
    }
}

__device__ __forceinline__ void mid_phase(const Params& p, int l, LAS unsigned char* lds, int tid, int wid, int lane, int item0, int item_end, int item_step) {
    constexpr int PITCH = 136;
    LAS bf16_t* WsL = (LAS bf16_t*)lds;
    LAS bf16_t* VsT = (LAS bf16_t*)(lds + 128 * PITCH * 2);
    LAS float* St = (LAS float*)(lds + RING_BYTES);
    const bf16_t* MIX = (const bf16_t*)(p.ws + WS_MIX);
    bf16_t* AIN = (bf16_t*)(p.ws + WS_AIN); bf16_t* BIN = (bf16_t*)(p.ws + WS_BIN); bf16_t* CIN = (bf16_t*)(p.ws + WS_CIN);
    for (int item = item0; item < item_end; item += item_step) {
        const int rb = item >> 2, q = item & 3, r0 = rb * 128; const bool smp = rb >= TP / 128;
        asm volatile("" : "+v"(tid), "+v"(lane));
        u32x4 vraw[2][2]; unsigned long long uraw[8];
        {
            u32x4 raw[16];
#pragma unroll
            for (int rr = 0; rr < 16; ++rr) raw[rr] = *(const u32x4*)(MIX + (size_t)(r0 + wid * 16 + rr) * DIN + 512 + lane * 8);
#pragma unroll
            for (int k = 0; k < 2; ++k) { const int s0 = 2 * ((tid >> 4) + 32 * k); const bf16_t* vp = MIX + (size_t)(r0 + s0) * DIN + 512 + q * 128 + (tid & 15) * 8;
                vraw[k][0] = *(const u32x4*)vp; vraw[k][1] = *(const u32x4*)(vp + DIN); }
#pragma unroll
            for (int n = 0; n < 8; ++n) uraw[n] = *(const unsigned long long*)(MIX + (size_t)(r0 + 16 * wid + (lane & 15)) * DIN + q * 128 + 16 * n + 4 * (lane >> 4));
#pragma unroll
            for (int rr = 0; rr < 16; ++rr) { const int row = wid * 16 + rr;
                float f[8]; unpack8(raw[rr], f);
                float s = ((f[0] + f[1]) + (f[2] + f[3])) + ((f[4] + f[5]) + (f[6] + f[7]));
                const float mean = wave_sum(s) * (1.0f / 512.0f); float qv = 0.f;
#pragma unroll
                for (int j = 0; j < 8; ++j) { const float d = f[j] - mean; qv += d * d; }
                const float rstd = rsqrtf(wave_sum(qv) * (1.0f / 512.0f) + EPS);
                if (lane == 0) { St[2 * row] = mean; St[2 * row + 1] = rstd; } }
        }
        {
            const float* wsg = p.wsp + (size_t)(l * 4 + q) * 128 * 128;
#pragma unroll
            for (int k = 0; k < 4; ++k) { const int idx = tid + 512 * k, t = idx >> 4, s8 = (idx & 15) * 8;
                float w8[8];
                if (!smp) { load8f(wsg + t * 128 + s8, w8);
#pragma unroll
                    for (int e = 0; e < 8; ++e) w8[e] = (s8 + e <= t) ? w8[e] : 0.f; }
                else {
#pragma unroll
                    for (int e = 0; e < 8; ++e) { const int j = s8 + e; const bool on = ((j >> 2) == (t >> 2)) && ((j & 3) <= (t & 3)); w8[e] = on ? wsg[(t & 3) * 128 + (j & 3)] : 0.f; } }
                *(LAS u32x4*)(WsL + t * PITCH + s8) = pack8(w8); }
        }
        __syncthreads();
        const int cg8 = tid & 15, rq = tid >> 4, ch = q * 128 + cg8 * 8;
        {
            float g8[8], b8[8]; load8f(p.lng + l * 512 + ch, g8); load8f(p.lnb + l * 512 + ch, b8);
#pragma unroll
            for (int k = 0; k < 2; ++k) { const int s0 = 2 * (rq + 32 * k);
                float fa[8], fb[8]; unpack8(vraw[k][0], fa); unpack8(vraw[k][1], fb);
                const float ma = St[2 * s0], ra = St[2 * s0 + 1], mb = St[2 * s0 + 2], rb2 = St[2 * s0 + 3];
#pragma unroll
                for (int j = 0; j < 8; ++j) { fa[j] = (fa[j] - ma) * ra * g8[j] + b8[j]; fb[j] = (fb[j] - mb) * rb2 * g8[j] + b8[j]; }
                if (smp) { store8f(p.out + O_V_S + ((size_t)l * 512 + (r0 - TP + s0)) * 512 + ch, fa); store8f(p.out + O_V_S + ((size_t)l * 512 + (r0 - TP + s0 + 1)) * 512 + ch, fb);
}
#pragma unroll
                for (int j = 0; j < 8; ++j) *(LAS unsigned*)(VsT + (cg8 * 8 + j) * PITCH + s0) = cvt_pk_bf16(fa[j], fb[j]); }
        }
        __syncthreads();
        {
            const int fr = lane & 15, fq = lane >> 4;
            f32x4 acc[8];
#pragma unroll
            for (int n = 0; n < 8; ++n) acc[n] = (f32x4){0.f, 0.f, 0.f, 0.f};
            const int nkb = (wid >> 1) + 1;
            for (int kb = 0; kb < nkb; ++kb) {
                const bf16x8 af = *(const LAS bf16x8*)(WsL + (16 * wid + fr) * PITCH + kb * 32 + 8 * fq);
#pragma unroll
                for (int n = 0; n < 8; ++n) { const bf16x8 bfr = *(const LAS bf16x8*)(VsT + (16 * n + fr) * PITCH + kb * 32 + 8 * fq);
                    acc[n] = __builtin_amdgcn_mfma_f32_16x16x32_bf16(bfr, af, acc[n], 0, 0, 0); }
            }
            const int t = 16 * wid + fr; const size_t row = (size_t)(r0 + t);
            const float bias = p.bs[(l * 4 + q) * 128 + (smp ? (t & 3) : t)];
#pragma unroll
            for (int n = 0; n < 8; ++n) { const int c0 = q * 128 + 16 * n + 4 * fq;
                const unsigned long long uw = uraw[n];
                const unsigned lo = (unsigned)uw, hi = (unsigned)(uw >> 32);
                const float o0 = bf_lo(lo) * (acc[n][0] + bias), o1 = bf_hi(lo) * (acc[n][1] + bias), o2 = bf_lo(hi) * (acc[n][2] + bias), o3 = bf_hi(hi) * (acc[n][3] + bias);
                *(unsigned long long*)(AIN + row * 512 + c0) = (unsigned long long)cvt_pk_bf16(o0, o1) | ((unsigned long long)cvt_pk_bf16(o2, o3) << 32); }
        }
        {
            const size_t rg = (size_t)(r0 + 4 * rq);
            if (q == 0) bc_group<2>(p, l, smp, rg, ch, MIX, BIN, CIN); else if (q == 1) bc_group<4>(p, l, smp, rg, ch, MIX, BIN, CIN);
            else if (q == 2) bc_group<8>(p, l, smp, rg, ch, MIX, BIN, CIN); else bc_group<16>(p, l, smp, rg, ch, MIX, BIN, CIN);
        }
        __syncthreads();
    }
}

#define XB_TMO      128
#define XB_XCNT(j)  (256  + 64 * (j))
#define XB_XSUB(j)  (1280 + 64 * (j))
#define XB_XGEN(j)  (2304 + 64 * (j))
#define XB_TOP      3328
#define XB_TOPGEN   3392
#define XCD_BAR_WORDS 3456
#define XB_SPIN_CAP (1u << 18)
__device__ __forceinline__ unsigned xb_ld(unsigned* p)              { return __hip_atomic_load(p, __ATOMIC_RELAXED, __HIP_MEMORY_SCOPE_AGENT); }
__device__ __forceinline__ unsigned xb_add(unsigned* p, unsigned v) { return __hip_atomic_fetch_add(p, v, __ATOMIC_RELAXED, __HIP_MEMORY_SCOPE_AGENT); }
__device__ __forceinline__ unsigned xb_xcc_id() { return (unsigned)__builtin_amdgcn_s_getreg((3 << 11) | 20) & 0xFu; }
#define XB_SPIN(cond, bar) do { unsigned _sp = 0; while (cond) { __builtin_amdgcn_s_sleep(1); \
    if ((++_sp & 255u) == 0u) { if (xb_ld(&(bar)[XB_TMO])) break; if (_sp > XB_SPIN_CAP) { atomicAdd(&(bar)[XB_TMO], 1u); break; } } } } while (0)
struct XcdBarrier { unsigned* bar; unsigned x; volatile LAS unsigned* st; };
__device__ __forceinline__ XcdBarrier xcd_barrier_post(unsigned* bar, volatile LAS unsigned* st) {
    XcdBarrier b; b.bar = bar; b.x = xb_xcc_id(); b.st = st;
    if (threadIdx.x == 0) (void)xb_add(&bar[XB_XCNT(b.x)], 1u);
    return b;
}
__device__ __forceinline__ void xcd_barrier_complete(unsigned* bar, unsigned x, unsigned& nloc, unsigned& nx) {
    const unsigned G = gridDim.x * gridDim.y * gridDim.z;
    unsigned sum, cnt, mine, sp = 0u;
    for (;;) {
        sum = 0u; cnt = 0u; mine = 0u;
#pragma unroll
        for (unsigned j = 0; j < 16; ++j) { const unsigned c = xb_ld(&bar[XB_XCNT(j)]); sum += c; cnt += (c > 0u) ? 1u : 0u; mine = (j == x) ? c : mine; }
        if (sum == G) break;
        __builtin_amdgcn_s_sleep(1);
        if ((++sp & 255u) == 0u) { if (xb_ld(&bar[XB_TMO])) break; if (sp > XB_SPIN_CAP) { atomicAdd(&bar[XB_TMO], 1u); break; } }
    }
    nloc = mine > 0u ? mine : 1u; nx = cnt > 0u ? cnt : 1u;
}
__device__ __forceinline__ void xcd_barrier(const XcdBarrier& b) {
    asm volatile("s_waitcnt vmcnt(0)" ::: "memory");
    __syncthreads();
    if (threadIdx.x == 0) {
        unsigned* bar = b.bar;
        __builtin_amdgcn_s_waitcnt(0);
        asm volatile("buffer_inv sc1" ::: "memory");
        unsigned nloc = b.st[0], nx = b.st[1];
        if (nloc == 0u) { xcd_barrier_complete(bar, b.x, nloc, nx); b.st[0] = nloc; b.st[1] = nx; }
        const unsigned old = xb_add(&bar[XB_XSUB(b.x)], 1u);
        const unsigned gen = old / nloc;
        if (old + 1u == (gen + 1u) * nloc) {
            __builtin_amdgcn_fence(__ATOMIC_RELEASE, "agent");
            asm volatile("s_waitcnt vmcnt(0)" ::: "memory");
            const unsigned og = xb_add(&bar[XB_TOP], 1u);
            const unsigned tg = og / nx;
            if (og + 1u == (tg + 1u) * nx) xb_add(&bar[XB_TOPGEN], 1u);
            else XB_SPIN(xb_ld(&bar[XB_TOPGEN]) == tg, bar);
            asm volatile("" ::: "memory");
            xb_add(&bar[XB_XGEN(b.x)], 1u);
            asm volatile("s_waitcnt vmcnt(0)" ::: "memory");
        } else {
            XB_SPIN(xb_ld(&bar[XB_XGEN(b.x)]) == gen, bar);
            asm volatile("s_waitcnt vmcnt(0)" ::: "memory");
        }
    }
    __syncthreads();
}

__global__ void __launch_bounds__(NTHREADS, 2) mk_fwd(Params p) {
    extern __shared__ __attribute__((aligned(16))) unsigned char lds_raw[];
    LAS unsigned char* lds = (LAS unsigned char*)lds_raw;
    const int G = gridDim.x, c = blockIdx.x;
#define TIDS() int tid = threadIdx.x; asm volatile("" : "+v"(tid)); const int wid = __builtin_amdgcn_readfirstlane(tid >> 6), lane = tid & 63; (void)wid; (void)lane
    int ph = 0;
#if MK_COOP
    cg::grid_group grid = cg::this_grid();
    volatile LAS unsigned* bst = (volatile LAS unsigned*)(lds + RING_BYTES + 2048);
    if (threadIdx.x < 2) bst[threadIdx.x] = 0u;
    __syncthreads();
    const XcdBarrier xbar = xcd_barrier_post((unsigned*)(p.ws + WS_CTL), bst);
    if (p.ph_hi > 100000) grid.sync();
#define SEAM() do { if (ph + 1 < p.ph_hi) xcd_barrier(xbar); } while (0)
#else
#define SEAM() do { } while (0)
#endif
#ifndef PR_PREP
#define PR_PREP 1
#endif
#ifndef PR_MID
#define PR_MID 1
#endif
#ifndef PR_GEMM
#define PR_GEMM 1
#endif
#ifndef PR_SYNC
#define PR_SYNC 1
#endif
#define RUNR(rep, ...) do { if (ph >= p.ph_lo && ph < p.ph_hi) { _Pragma("unroll 1") for (int rep_ = 0; rep_ < (rep); ++rep_) { __VA_ARGS__; } _Pragma("unroll 1") for (int rep_ = 0; rep_ < PR_SYNC; ++rep_) SEAM(); } ++ph; } while (0)
#ifndef PR_NORM
#define PR_NORM 0
#endif
#ifndef PR_GU
#define PR_GU 1
#endif
#ifndef PR_DN
#define PR_DN 1
#endif
#ifndef PR_IN
#define PR_IN 1
#endif
#ifndef PR_BR
#define PR_BR 1
#endif
#ifndef PR_WO
#define PR_WO 1
#endif
#define RUN(...) RUNR(1, __VA_ARGS__)
#define RUNG(...) RUNR(PR_GEMM, __VA_ARGS__)
    const bf16_t* Hb = (const bf16_t*)(p.ws + WS_H);
    bf16_t* ACT = (bf16_t*)(p.ws + WS_MIX);
    bf16_t* MIX = (bf16_t*)(p.ws + WS_MIX);
    bf16_t* Mb = (bf16_t*)(p.ws + WS_M);
    const float* RSb = (const float*)(p.ws + WS_RS);
    float* Pb = (float*)(p.ws + WS_P);
    bf16_t* MG = (bf16_t*)(p.ws + WS_MG);

    RUNR(PR_PREP, { TIDS(); norm_phase(p, 0, 0.5f, p.ng, 11, wid, lane, false, false); prep_phase(p, lds, tid, wid, lane); });
#pragma unroll 1
    for (int l = 0; l < DEPTH; ++l) {
        const float* g = p.ng + (size_t)l * 6 * D;
#pragma unroll 1
        for (int j = 0; j < 2; ++j) {
            RUNR(PR_GEMM * PR_GU, {
                  const bool has_sn = !(l == 0 && j == 0);
                  unsigned* sn = (unsigned*)(p.ws + WS_CTL + CTL_SN) + 64 * (j == 0 ? (l * 3 - 1) : (l * 3 + 1));
                  if (has_sn && rep_ == 0) { if (j == 0) sample_norm_head(p, 0.5f, g - D, 11, sn, c, G); else sample_norm_head(p, 1.0f, g + 3 * D, 8, sn, c, G); }
                  Sched S; S.nM = T / BM; S.nN = 2 * FF / BM; S.nwg = S.nM * S.nN; S.G = G; S.c = c; S.ready = nullptr; S.need = 0; S.xfirst = 0; S.nsub = 1; S.nt = D / BK; S.xS = 0; S.xnt = 0; S.xKS = 1; S.xA0 = nullptr; S.xAp = 0; S.tstep = (size_t)BM * D * 2;
                  S.dA = S.dB = 0; S.A0 = (const char*)Hb; S.B0 = (const char*)(p.ws + WS_WGU + (size_t)(l * 2 + j) * SZ_WGU);
                  if (has_sn) { S.ready = sn; S.need = 64u; }
                  EpiSwiGLU E{ACT, RSb}; gemm_phase<EpiSwiGLU>(lds, D, S, E);
                  { const int rem = S.nwg % G; if (rep_ == 0 && rem != 0 && c >= rem) prep_window(p, l, j == 0 ? 0 : 3, lds, c - rem, G - rem); } });
            RUNR(PR_GEMM * PR_DN, { Sched S; S.nM = TP / BM; S.nN = D / BM; S.nwg = S.nM * S.nN; S.G = G; S.c = c; S.ready = nullptr; S.need = 0; S.xfirst = 1; S.nsub = 1; S.nt = FF / BK; S.xS = 11; S.xnt = 4; S.xKS = 11; S.xA0 = (const char*)ACT + (size_t)64 * BM * FF * 2; S.xAp = 0; S.tstep = (size_t)BM * FF * 2;
                  S.dA = S.dB = 0; S.A0 = (const char*)ACT; S.B0 = (const char*)(p.ws + WS_WDN + (size_t)(l * 2 + j) * SZ_WDN);
                  unsigned* pc = (unsigned*)(p.ws + WS_CTL + 16384) + (size_t)((l * 3 + (j == 0 ? 0 : 2)) * 2) * 64 * 16;
                  EpiM E{Pb, (bf16_t*)(p.ws + WS_H), (float*)(p.ws + WS_RS), p.out, g + (j == 0 ? 1 : 5) * D, 0.5f, (float*)(p.ws + WS_X1), (float*)(p.ws + WS_X2), pc, pc + 64 * 16, (j == 1 && l == DEPTH - 1) ? 1 : 0};
                  gemm_phase<EpiM>(lds, FF, S, E); });
            if (j == 0) {
                RUNR(PR_GEMM * PR_IN, {
                      unsigned* sn = (unsigned*)(p.ws + WS_CTL + CTL_SN) + 64 * (l * 3);
                      if (rep_ == 0) sample_norm_head(p, 0.5f, g + D, 11, sn, c, G);
                      Sched S; S.nM = T / BM; S.nN = DIN / BM; S.nwg = S.nM * S.nN; S.G = G; S.c = c; S.ready = nullptr; S.need = 0; S.xfirst = 0; S.nsub = 1; S.nt = D / BK; S.xS = 0; S.xnt = 0; S.xKS = 1; S.xA0 = nullptr; S.xAp = 0; S.tstep = (size_t)BM * D * 2;
                      S.dA = S.dB = 0; S.A0 = (const char*)Hb; S.B0 = (const char*)(p.ws + WS_WIN + (size_t)l * SZ_WIN);
                      S.ready = sn; S.need = 64u;
                      EpiMix E{MIX, RSb}; gemm_phase<EpiMix>(lds, D, S, E);
                      { const int rem = S.nwg % G; if (rep_ == 0 && rem != 0 && c >= rem) prep_window(p, l, 1, lds, c - rem, G - rem); } });
                RUNR(PR_MID, { TIDS(); mid_phase(p, l, lds, tid, wid, lane, c, (TP / 128) * 4, G); });
                RUNR(PR_GEMM * PR_BR, {
                      unsigned* cnt = (unsigned*)(p.ws + WS_CTL) + 3520 + 64 * l;
                      if (rep_ == 0 && c >= G - 16) { TIDS(); mid_phase(p, l, lds, tid, wid, lane, (TP / 128) * 4 + (c - (G - 16)), (TP / 128) * 4 + (c - (G - 16)) + 1, 1);
                          asm volatile("s_waitcnt vmcnt(0)" ::: "memory"); __syncthreads();
                          if (threadIdx.x == 0) { __builtin_amdgcn_fence(__ATOMIC_RELEASE, "agent"); asm volatile("s_waitcnt vmcnt(0)" ::: "memory");
                              __hip_atomic_fetch_add(cnt, 1u, __ATOMIC_RELAXED, __HIP_MEMORY_SCOPE_AGENT); } }
                      Sched S; S.nM = TP / BM; S.nN = D / BM; S.nwg = S.nM * S.nN; S.G = G; S.c = c; S.ready = cnt; S.need = 16u; S.xfirst = 0; S.nsub = 3; S.nt = 512 / BK; S.xS = 2; S.xnt = 4; S.xKS = 2; S.xA0 = (const char*)(p.ws + WS_AIN) + (size_t)64 * BM * 512 * 2; S.xAp = 0; S.tstep = (size_t)BM * 512 * 2;
                      S.A0 = (const char*)(p.ws + WS_AIN); S.dA = WS_BIN - WS_AIN; S.B0 = (const char*)(p.ws + WS_WA + (size_t)l * SZ_WBR); S.dB = WS_WB - WS_WA;
                      EpiBranch E{MIX + 3072, MG, (bf16_t*)(p.ws + WS_MGP)}; gemm_phase<EpiBranch>(lds, 512, S, E);
                      if (rep_ == 0 && c >= 16 && c < G - 16) prep_window(p, l, 2, lds, c - 16, G - 32);
                      });

                RUNR(PR_GEMM * PR_WO, { Sched S; S.nM = TP / BM; S.nN = D / BM; S.nwg = S.nM * S.nN; S.G = G; S.c = c; S.ready = nullptr; S.need = 0; S.xfirst = 1; S.nsub = 1; S.nt = D / BK; S.xS = 8; S.xnt = 4; S.xKS = 4; S.xA0 = (const char*)(p.ws + WS_MGP); S.xAp = (size_t)TS * D * 2; S.tstep = (size_t)BM * D * 2;
                      S.dA = S.dB = 0; S.A0 = (const char*)MG; S.B0 = (const char*)(p.ws + WS_WO + (size_t)l * SZ_WO);
                      unsigned* pc = (unsigned*)(p.ws + WS_CTL + 16384) + (size_t)((l * 3 + 1) * 2) * 64 * 16;
                      EpiM E{Pb, (bf16_t*)(p.ws + WS_H), (float*)(p.ws + WS_RS), p.out, g + 3 * D, 1.0f, (float*)(p.ws + WS_X1), (float*)(p.ws + WS_X2), pc, pc + 64 * 16, 0};
                      gemm_phase<EpiM>(lds, D, S, E); });
            }
        }
    }
    RUN({ TIDS(); norm_phase(p, 2, 0.5f, p.ng + (size_t)(3 * 6 + 5) * D, 11, wid, lane, false, true); });
#undef RUN
#undef RUNG
#undef RUNR
#undef SEAM
}
constexpr int N_PHASES = 1 + DEPTH * 8 + 1;

extern "C" void kernel_launch(void* const* d_in, const int* in_sizes, int n_in, void* d_out, int out_size, void* d_ws, size_t ws_size, hipStream_t stream) {
    static int grid = 0;
    if (grid == 0) {
        if (n_in != 19 || (size_t)out_size != O_END || ws_size < WS_END) { fprintf(stderr, "kernel_launch: unexpected shapes (n_in %d out %d ws %zu need %zu)\n", n_in, out_size, ws_size, (size_t)WS_END); grid = -1; return; }
        int dev = 0, cus = 0, per_cu = 0;
        (void)hipGetDevice(&dev); (void)hipDeviceGetAttribute(&cus, hipDeviceAttributeMultiprocessorCount, dev);
        if (hipFuncSetAttribute((const void*)mk_fwd, hipFuncAttributeMaxDynamicSharedMemorySize, LDS_BYTES) != hipSuccess) { fprintf(stderr, "kernel_launch: hipFuncSetAttribute failed\n"); grid = -1; return; }
        if (hipOccupancyMaxActiveBlocksPerMultiprocessor(&per_cu, (const void*)mk_fwd, NTHREADS, LDS_BYTES) != hipSuccess || per_cu < 1) { fprintf(stderr, "kernel_launch: occupancy query says %d\n", per_cu); per_cu = 1; }
        (void)hipGetLastError();
        grid = cus * 1;
        fprintf(stderr, "kernel_launch: cus %d per_cu %d grid %d\n", cus, per_cu, grid);
    }
    if (grid < 0) return;
    if (hipMemsetAsync((char*)d_ws + WS_CTL, 0, CTL_BYTES, stream) != hipSuccess) { fprintf(stderr, "kernel_launch: memset failed\n"); return; }
    Params p{};
    p.xp = (const float*)d_in[0]; p.xs = (const float*)d_in[1]; p.sconv = (const float*)d_in[2]; p.spool = (const float*)d_in[3]; p.ng = (const float*)d_in[4];
    p.wgu = (const float*)d_in[5]; p.wdn = (const float*)d_in[6]; p.win = (const float*)d_in[7]; p.wsp = (const float*)d_in[8]; p.bs = (const float*)d_in[9];
    p.lng = (const float*)d_in[10]; p.lnb = (const float*)d_in[11]; p.wconv = (const float*)d_in[12]; p.wpool = (const float*)d_in[13]; p.pscale = (const float*)d_in[14];
    p.wa = (const float*)d_in[15]; p.wb = (const float*)d_in[16]; p.wc = (const float*)d_in[17]; p.wo = (const float*)d_in[18];
    p.out = (float*)d_out; p.ws = (unsigned char*)d_ws;
#if MK_COOP
    p.ph_lo = 0; p.ph_hi = N_PHASES;
    void* args[] = {&p};
    hipError_t e = hipLaunchCooperativeKernel((const void*)mk_fwd, dim3(grid), dim3(NTHREADS), args, LDS_BYTES, stream);
    if (e != hipSuccess) fprintf(stderr, "cooperative launch failed: %s (grid %d)\n", hipGetErrorString(e), grid);
#else
    for (int k = 0; k < N_PHASES; ++k) { p.ph_lo = k; p.ph_hi = k + 1; hipLaunchKernelGGL(mk_fwd, dim3(grid), dim3(NTHREADS), LDS_BYTES, stream, p); }
#endif
}
```
